# Optimizing an MI355X kernel written in HIP

```python
import jax, jax.numpy as jnp
from jax import lax
import numpy as np

D_MODEL = 2048
BATCH = 2
SEQ = 4096
DEPTH = 1
DEC_BATCH = 32
DEC_SEQ = 1
PAST_LEN = 16384
PAGE_SIZE = 128

HEAD_DIM = 128
N_ATTN_HEADS = D_MODEL // (2 * HEAD_DIM)
N_KV_HEADS = 2
GQA_GROUP = N_ATTN_HEADS // N_KV_HEADS
ATTN_WIDTH = N_ATTN_HEADS * HEAD_DIM
WINDOW = 128
ATTN_BLOCK = 128
N_RET_HEADS = D_MODEL // 256
RET_QK_DIM = (D_MODEL // 2) // N_RET_HEADS
RET_V_DIM = RET_QK_DIM
RET_WIDTH = N_RET_HEADS * RET_V_DIM
RET_CHUNK = 128
MIX_WIDTH = ATTN_WIDTH + RET_WIDTH
D_FF = -(-8 * D_MODEL // (3 * 256)) * 256
PLE_DIM = 256
ROPE_BASE = 10000.0
NORM_EPS = 1e-6
ATTN_SCALE = HEAD_DIM ** -0.5
RET_K_SCALE = RET_QK_DIM ** -0.5
_SPLIT_SIZES = (ATTN_WIDTH, N_KV_HEADS * HEAD_DIM, N_KV_HEADS * HEAD_DIM,
                N_RET_HEADS * RET_QK_DIM, N_RET_HEADS * RET_QK_DIM, RET_WIDTH, RET_WIDTH)
_SPLIT_POINTS = tuple(int(c) for c in np.cumsum(_SPLIT_SIZES)[:-1])
IN_WIDTH = sum(_SPLIT_SIZES)

kernel_name = 'hybrid_swa_sink_retention_decoder_step'


def _rms_norm(x, g):
    xf = x.astype(jnp.float32)
    y = xf * lax.rsqrt(jnp.mean(xf * xf, axis=-1, keepdims=True) + NORM_EPS)
    return (y * g.astype(jnp.float32)).astype(x.dtype)


def _rotary(x, pos):
    half = x.shape[-1] // 2
    inv = ROPE_BASE ** (-jnp.arange(half, dtype=jnp.float32) / half)
    ang = pos.astype(jnp.float32)[:, None] * inv[None, :]
    cos = jnp.cos(ang)[None, :, None, :]
    sin = jnp.sin(ang)[None, :, None, :]
    xf = x.astype(jnp.float32)
    x1, x2 = xf[..., :half], xf[..., half:]
    return jnp.concatenate([x1 * cos - x2 * sin, x1 * sin + x2 * cos], axis=-1)


def _sink_softmax(s, mask, sink):
    s = jnp.where(mask, s, -jnp.inf)
    m = jnp.maximum(jnp.max(s, axis=-1), sink)
    e = jnp.exp(s - m[..., None])
    denom = jnp.sum(e, axis=-1) + jnp.exp(sink - m)
    return e / denom[..., None]


def _swa_prompt(q, k, v, sinks):
    b, t = q.shape[0], q.shape[1]
    nb = t // ATTN_BLOCK
    qb = q.reshape(b, nb, ATTN_BLOCK, N_KV_HEADS, GQA_GROUP, HEAD_DIM)

    def band(a):
        ap = jnp.pad(a, ((0, 0), (ATTN_BLOCK, 0), (0, 0), (0, 0)))
        ap = ap.reshape(b, nb + 1, ATTN_BLOCK, N_KV_HEADS, HEAD_DIM)
        return jnp.concatenate([ap[:, :-1], ap[:, 1:]], axis=2)

    kb, vb = band(k), band(v)
    blk = jnp.arange(nb)[:, None]
    qpos = blk * ATTN_BLOCK + jnp.arange(ATTN_BLOCK)[None, :]
    kpos = (blk - 1) * ATTN_BLOCK + jnp.arange(2 * ATTN_BLOCK)[None, :]
    dist = qpos[:, :, None] - kpos[:, None, :]
    mask = (dist >= 0) & (dist <= WINDOW) & (kpos[:, None, :] >= 0)
    s = jnp.einsum('bnqhgd,bnkhd->bnhgqk', qb, kb, preferred_element_type=jnp.float32) * ATTN_SCALE
    sink = sinks.astype(jnp.float32).reshape(N_KV_HEADS, GQA_GROUP)[None, None, :, :, None]
    p = _sink_softmax(s, mask[None, :, None, None], sink)
    o = jnp.einsum('bnhgqk,bnkhd->bnqhgd', p.astype(vb.dtype), vb)
    return o.reshape(b, t, ATTN_WIDTH)


def _swa_sample(q, k, v, k_buf, v_buf, sinks):
    b, t = q.shape[0], q.shape[1]
    w = k_buf.shape[1]
    kk = jnp.concatenate([k_buf.astype(k.dtype), k], axis=1)
    vv = jnp.concatenate([v_buf.astype(v.dtype), v], axis=1)
    qpos = PAST_LEN + jnp.arange(t)
    kpos = PAST_LEN - w + jnp.arange(w + t)
    dist = qpos[:, None] - kpos[None, :]
    mask = (dist >= 0) & (dist <= WINDOW)
    qg = q.reshape(b, t, N_KV_HEADS, GQA_GROUP, HEAD_DIM)
    s = jnp.einsum('bqhgd,bkhd->bhgqk', qg, kk, preferred_element_type=jnp.float32) * ATTN_SCALE
    sink = sinks.astype(jnp.float32).reshape(N_KV_HEADS, GQA_GROUP)[None, :, :, None]
    p = _sink_softmax(s, mask, sink)
    o = jnp.einsum('bhgqk,bkhd->bqhgd', p.astype(vv.dtype), vv).reshape(b, t, ATTN_WIDTH)
    return o, kk[:, -w:], vv[:, -w:]


def _ret_log_decay():
    return jnp.log1p(-jnp.exp2(-5.0 - jnp.arange(N_RET_HEADS, dtype=jnp.float32)))


def _retention(q, k, v, s0):
    b, t, h = q.shape[0], q.shape[1], q.shape[2]
    c = RET_CHUNK if t % RET_CHUNK == 0 else t
    nc = t // c
    lg = _ret_log_decay()
    idx = jnp.arange(c, dtype=jnp.float32)
    diff = idx[:, None] - idx[None, :]
    intra = jnp.where(diff >= 0, jnp.exp(lg[:, None, None] * jnp.maximum(diff, 0.0)), 0.0)
    q_dec = jnp.exp(lg[:, None] * (idx[None, :] + 1.0))[None, :, :, None]
    k_dec = jnp.exp(lg[:, None] * (c - 1.0 - idx[None, :]))[None, :, :, None]
    chunk_dec = jnp.exp(lg * c)[None, :, None, None]

    def to_chunks(a):
        return a.reshape(b, nc, c, h, a.shape[-1]).transpose(1, 0, 3, 2, 4)

    def step(s, inp):
        qc, kc, vc = inp
        sc = jnp.einsum('bhcd,bhed->bhce', qc, kc) * intra
        o = jnp.einsum('bhce,bhev->bhcv', sc, vc) + jnp.einsum('bhcd,bhdv->bhcv', qc * q_dec, s)
        s = s * chunk_dec + jnp.einsum('bhcd,bhcv->bhdv', kc * k_dec, vc)
        return s, o

    s_final, o = lax.scan(step, s0, (to_chunks(q), to_chunks(k), to_chunks(v)))
    o = o.transpose(1, 0, 3, 2, 4).reshape(b, t, h, v.shape[-1])
    return o, s_final


def _layer(h, pe, k_buf, v_buf, s0, pos, wts):
    (an, w_in, qn, kn, sinks, rg, w_out, fn, w_gate, w_up, w_down, pn, w_ple, w_pg) = wts
    b, t = h.shape[0], h.shape[1]
    a = _rms_norm(h, an)
    z = a @ w_in
    aq, ak, av, rq, rk, rv, rgate = jnp.split(z, _SPLIT_POINTS, axis=-1)
    aq = _rms_norm(aq.reshape(b, t, N_ATTN_HEADS, HEAD_DIM), qn)
    ak = _rms_norm(ak.reshape(b, t, N_KV_HEADS, HEAD_DIM), kn)
    av = av.reshape(b, t, N_KV_HEADS, HEAD_DIM)
    if k_buf is None:
        o_attn = _swa_prompt(aq, ak, av, sinks)
        w = min(WINDOW, t)
        nk, nv = ak[:, -w:], av[:, -w:]
    else:
        o_attn, nk, nv = _swa_sample(aq, ak, av, k_buf, v_buf, sinks)
    rq = _rotary(rq.reshape(b, t, N_RET_HEADS, RET_QK_DIM), pos)
    rk = _rotary(rk.reshape(b, t, N_RET_HEADS, RET_QK_DIM), pos) * RET_K_SCALE
    rv = rv.reshape(b, t, N_RET_HEADS, RET_V_DIM).astype(jnp.float32)
    o_ret, s_new = _retention(rq, rk, rv, s0.astype(jnp.float32))
    o_ret = o_ret * lax.rsqrt(jnp.mean(o_ret * o_ret, axis=-1, keepdims=True) + NORM_EPS)
    o_ret = o_ret.reshape(b, t, RET_WIDTH) * rg.astype(jnp.float32) * jax.nn.silu(rgate.astype(jnp.float32))
    mix = jnp.concatenate([o_attn, o_ret.astype(h.dtype)], axis=-1)
    h = h + mix @ w_out
    f = _rms_norm(h, fn)
    h = h + (jax.nn.silu(f @ w_gate) * (f @ w_up)) @ w_down
    h = h + (pe @ w_ple) * jax.nn.sigmoid(_rms_norm(h, pn) @ w_pg)
    return h, nk, nv, s_new.astype(h.dtype)


def setup_inputs(seed: int = 0) -> dict:
    key = jax.random.key(seed)
    ks = jax.random.split(key, 24)
    f32 = jnp.float32
    n = lambda i, shape: jax.random.normal(ks[i], shape, f32)
    cache_win = min(WINDOW, PAST_LEN)
    return {
        'x_prompt': n(0, (BATCH, SEQ, D_MODEL)),
        'x_sample': n(1, (DEC_BATCH, DEC_SEQ, D_MODEL)),
        'cache_k_win': n(2, (DEPTH, DEC_BATCH, cache_win, N_KV_HEADS, HEAD_DIM)),
        'cache_v_win': n(3, (DEPTH, DEC_BATCH, cache_win, N_KV_HEADS, HEAD_DIM)),
        'state_ret': n(4, (DEPTH, DEC_BATCH, N_RET_HEADS, RET_QK_DIM, RET_V_DIM)),
        'p_prompt': n(5, (DEPTH, BATCH, SEQ, PLE_DIM)),
        'p_sample': n(6, (DEPTH, DEC_BATCH, DEC_SEQ, PLE_DIM)),
        'attn_norm_g': 1.0 + 0.05 * n(7, (DEPTH, D_MODEL)),
        'w_in': n(8, (DEPTH, D_MODEL, IN_WIDTH)) * D_MODEL ** -0.5,
        'q_norm_g': 1.0 + 0.05 * n(9, (DEPTH, HEAD_DIM)),
        'k_norm_g': 1.0 + 0.05 * n(10, (DEPTH, HEAD_DIM)),
        'attn_sinks': 0.5 * n(11, (DEPTH, N_ATTN_HEADS)),
        'ret_out_g': 1.0 + 0.05 * n(12, (DEPTH, RET_WIDTH)),
        'w_out': n(13, (DEPTH, MIX_WIDTH, D_MODEL)) * MIX_WIDTH ** -0.5,
        'ffn_norm_g': 1.0 + 0.05 * n(14, (DEPTH, D_MODEL)),
        'w_gate': n(15, (DEPTH, D_MODEL, D_FF)) * D_MODEL ** -0.5,
        'w_up': n(16, (DEPTH, D_MODEL, D_FF)) * D_MODEL ** -0.5,
        'w_down': n(17, (DEPTH, D_FF, D_MODEL)) * D_FF ** -0.5,
        'ple_norm_g': 1.0 + 0.05 * n(18, (DEPTH, D_MODEL)),
        'w_ple': n(19, (DEPTH, PLE_DIM, D_MODEL)) * PLE_DIM ** -0.5,
        'w_ple_gate': n(20, (DEPTH, D_MODEL, D_MODEL)) * D_MODEL ** -0.5,
    }


def reference(x_prompt, x_sample, cache_k_win, cache_v_win, state_ret, p_prompt, p_sample,
              attn_norm_g, w_in, q_norm_g, k_norm_g, attn_sinks, ret_out_g, w_out,
              ffn_norm_g, w_gate, w_up, w_down, ple_norm_g, w_ple, w_ple_gate):
    y_p, y_s = x_prompt, x_sample
    pos_p = jnp.arange(x_prompt.shape[1])
    pos_s = PAST_LEN + jnp.arange(x_sample.shape[1])
    kp_l, vp_l, sp_l, ks_l, vs_l, ss_l = [], [], [], [], [], []
    for l in range(DEPTH):
        wts = (attn_norm_g[l], w_in[l], q_norm_g[l], k_norm_g[l], attn_sinks[l], ret_out_g[l], w_out[l],
               ffn_norm_g[l], w_gate[l], w_up[l], w_down[l], ple_norm_g[l], w_ple[l], w_ple_gate[l])
        s0 = jnp.zeros((x_prompt.shape[0], N_RET_HEADS, RET_QK_DIM, RET_V_DIM), jnp.float32)
        y_p, kp, vp, sp = _layer(y_p, p_prompt[l], None, None, s0, pos_p, wts)
        y_s, kd, vd, sd = _layer(y_s, p_sample[l], cache_k_win[l], cache_v_win[l], state_ret[l], pos_s, wts)
        kp_l.append(kp); vp_l.append(vp); sp_l.append(sp)
        ks_l.append(kd); vs_l.append(vd); ss_l.append(sd)
    k_win_prompt = jnp.stack(kp_l)
    v_win_prompt = jnp.stack(vp_l)
    ret_state_prompt = jnp.stack(sp_l)
    k_win_sample = jnp.stack(ks_l)
    v_win_sample = jnp.stack(vs_l)
    ret_state_sample = jnp.stack(ss_l)
    return (y_p, y_s, k_win_prompt, v_win_prompt, ret_state_prompt, k_win_sample, v_win_sample, ret_state_sample)
```

```cpp
#include <hip/hip_runtime.h>
#include <hip/hip_cooperative_groups.h>
#include <cstdio>
namespace cg = cooperative_groups;
namespace pg8 {
#define PG8_LAS __attribute__((address_space(3)))
typedef unsigned short bf16_t;
typedef short bf16x8 __attribute__((ext_vector_type(8)));
typedef float f32x4 __attribute__((ext_vector_type(4)));
typedef unsigned u32x4 __attribute__((ext_vector_type(4)));
constexpr int BM = 256, BK = 64, HALF = 128, HTB = HALF * BK * 2  , STAGE_BYTES = 8 * HTB, NXCD = 8, WGM = 8;

__host__ __device__ __forceinline__ int lds_byte(int r, int c) { const int st = (r >> 4) * 2 + (c >> 5), rr = r & 15, cc = c & 31, ob = rr * 64 + cc * 2; return st * 1024 + (ob ^ (((ob >> 9) & 1) << 5)); }
__host__ __device__ __forceinline__ void stage_rc(int b, int& R, int& C) { const int st = b / 1024, sb = b % 1024, swz = sb ^ (((sb >> 9) & 1) << 5); R = (st >> 1) * 16 + swz / 64; C = (st & 1) * 32 + (swz % 64) / 2; }
__host__ __device__ __forceinline__ int perm32(int rho) { const int n = rho >> 4, i = rho & 15; return 8 * (i >> 2) + 4 * n + (i & 3); }

struct Unit { int pm, pn; };
struct Gemm { const bf16_t* A; const bf16_t* Bt; int M, N, K; };

struct StaticOrder {
    int nM, nN, nwg, G, c;
    __host__ __device__ void init(int M, int N, int G_, int c_) { nM = M / BM; nN = N / BM; nwg = nM * nN; G = G_; c = c_; }
    __host__ __device__ bool next(int i, Unit& u) const {
        const long L = (long)i * G + c; if (L >= nwg) return false;
        int wgid = (int)L; { const int q = nwg / NXCD, r = nwg % NXCD, xcd = wgid % NXCD, off = wgid / NXCD; wgid = (xcd < r ? xcd * (q + 1) : r * (q + 1) + (xcd - r) * q) + off; }
        const int nig = WGM * nN, gid = wgid / nig, fm = gid * WGM, gsz = (nM - fm) < WGM ? (nM - fm) : WGM;
        u.pm = fm + ((wgid % nig) % gsz); u.pn = (wgid % nig) / gsz; return true;
    }
    __device__ __forceinline__ void a_ready(const Unit&) const {}
    __device__ __forceinline__ void done(const Unit&) const {}
};
__device__ __forceinline__ unsigned cvt_pk_bf16(float lo, float hi) { unsigned r; asm volatile("v_cvt_pk_bf16_f32 %0, %1, %2" : "=v"(r) : "v"(lo), "v"(hi)); return r; }
template <class Epi, class Sched, bool STAMP = false>
__device__ __forceinline__ void gemm_phase(PG8_LAS unsigned char* lds, const Gemm g, const Sched& S, const Epi& E, unsigned long long* stamps) {
    const int tid = threadIdx.x, wid = __builtin_amdgcn_readfirstlane(tid >> 6), lane = tid & 63, wr = wid >> 2, wc = wid & 3, fr = lane & 15, fq = lane >> 4;
    const int K = g.K, nt = K / BK;
    int ts_lo = 0, ts_hi = 0, nts = 0; const unsigned long long rt_entry = STAMP ? (unsigned long long)wall_clock64() : 0ull;
#define PG8_STAMP() do { if (STAMP && wid == 0 && nts < 64) { const unsigned long long _c = (unsigned long long)clock64(); \
        ts_lo = (lane == nts) ? (int)(unsigned)_c : ts_lo; ts_hi = (lane == nts) ? (int)(unsigned)(_c >> 32) : ts_hi; ++nts; } } while (0)
    PG8_STAMP();
    unsigned voffA[2], voffB[2];
#pragma unroll
    for (int i = 0; i < 2; ++i) { int R, C; stage_rc(tid * 16 + i * 8192, R, C); const int Rb = Epi::PERM ? ((R & ~31) + perm32(R & 31)) : R;
        voffA[i] = (unsigned)(R * K + C) * 2u; voffB[i] = (unsigned)(Rb * K + C) * 2u; }
    const size_t kstep = (size_t)(BK * 2);
    const size_t hstep = (size_t)HALF * K * 2;
    const size_t tstep = 2 * hstep;
    const unsigned ldsw = (unsigned)wid * 1024u;
    const int aoff = lds_byte(wr * 64 + fr, fq * 8), boff = lds_byte(wc * 32 + fr, fq * 8);
#define PG8_SA(b, h) (((b) * 2 + (h)) * HTB)
#define PG8_SB(b, h) ((4 + (b) * 2 + (h)) * HTB)
#define PG8_STAGE(bufoff, gbase, voff) do { _Pragma("unroll") for (int _i = 0; _i < 2; ++_i) \
        __builtin_amdgcn_global_load_lds((const unsigned*)((const char*)(gbase) + (voff)[_i]), (PG8_LAS unsigned*)(lds + (bufoff) + ldsw + _i * 8192), 16, 0, 0); } while (0)
#define PG8_LDA(dst, b, h) do { _Pragma("unroll") for (int m = 0; m < 4; ++m) _Pragma("unroll") for (int k = 0; k < 2; ++k) dst[m][k] = *(const PG8_LAS bf16x8*)(lds + PG8_SA(b, h) + aoff + m * 2048 + k * 1024); } while (0)
#define PG8_LDB(dst, b, h) do { _Pragma("unroll") for (int n = 0; n < 2; ++n) _Pragma("unroll") for (int k = 0; k < 2; ++k) dst[n][k] = *(const PG8_LAS bf16x8*)(lds + PG8_SB(b, h) + boff + n * 2048 + k * 1024); } while (0)
#define PG8_MMA(ai, bj, At, Bt) do { __builtin_amdgcn_s_setprio(1); _Pragma("unroll") for (int m = 0; m < 4; ++m) _Pragma("unroll") for (int n = 0; n < 2; ++n) _Pragma("unroll") for (int k = 0; k < 2; ++k) \
        acc[ai][bj][m][n] = __builtin_amdgcn_mfma_f32_16x16x32_bf16(Bt[n][k], At[m][k], acc[ai][bj][m][n], 0, 0, 0); __builtin_amdgcn_s_setprio(0); } while (0)
#define PG8_WAIT_V(n) asm volatile("s_waitcnt vmcnt(" #n ")" ::: "memory")
#define PG8_WAIT_L(n) asm volatile("s_waitcnt lgkmcnt(" #n ")" ::: "memory")
#define PG8_BAR __builtin_amdgcn_s_barrier()
#define PG8_SCHED __builtin_amdgcn_sched_barrier(0)
    Unit cur, nxt; int ui = 0;
    if (!S.next(0, cur)) return;
    f32x4 acc[2][2][4][2];
#pragma unroll
    for (int a = 0; a < 2; ++a)
#pragma unroll
        for (int b = 0; b < 2; ++b)
#pragma unroll
            for (int m = 0; m < 4; ++m)
#pragma unroll
                for (int n = 0; n < 2; ++n) acc[a][b][m][n] = (f32x4){0.f, 0.f, 0.f, 0.f};
    bf16x8 At[4][2], B0[2][2], B1[2][2];
    const char* cA = (const char*)g.A + (size_t)cur.pm * tstep; const char* cB = (const char*)g.Bt + (size_t)cur.pn * tstep;
    S.a_ready(cur);
    PG8_STAGE(PG8_SB(0, 0), cB, voffB); PG8_STAGE(PG8_SA(0, 0), cA, voffA); PG8_STAGE(PG8_SB(0, 1), cB + hstep, voffB); PG8_STAGE(PG8_SA(0, 1), cA + hstep, voffA);
    if (wr == 1) PG8_BAR;
    PG8_WAIT_V(4); PG8_BAR;
    PG8_STAGE(PG8_SB(1, 0), cB + kstep, voffB); PG8_STAGE(PG8_SA(1, 0), cA + kstep, voffA); PG8_STAGE(PG8_SB(1, 1), cB + hstep + kstep, voffB);
    PG8_WAIT_V(6); PG8_BAR;
    PG8_STAMP();
    for (;;) {
        const bool has_next = S.next(ui + 1, nxt);
        const char* nA = has_next ? (const char*)g.A + (size_t)nxt.pm * tstep : cA; const char* nB = has_next ? (const char*)g.Bt + (size_t)nxt.pn * tstep : cB;
        for (int t = 0; t < nt; t += 2) {
            const bool last = (t == nt - 2);
            const char* a1 = cA + (size_t)(t + 1) * kstep;
            const char* a2 = last ? nA : cA + (size_t)(t + 2) * kstep; const char* b2 = last ? nB : cB + (size_t)(t + 2) * kstep;
            const char* a3 = a2 + kstep; const char* b3 = b2 + kstep;
            if (last && has_next) S.a_ready(nxt);
            PG8_LDB(B0, 0, 0); PG8_SCHED; PG8_LDA(At, 0, 0); PG8_STAGE(PG8_SA(1, 1), a1 + hstep, voffA);
            PG8_WAIT_L(8); PG8_BAR; PG8_WAIT_L(0); PG8_MMA(0, 0, At, B0); PG8_BAR; PG8_SCHED;
            PG8_LDB(B1, 0, 1); PG8_STAGE(PG8_SB(0, 0), b2, voffB);
            PG8_BAR; PG8_WAIT_L(0); PG8_MMA(0, 1, At, B1); PG8_BAR;
            PG8_LDA(At, 0, 1); PG8_STAGE(PG8_SA(0, 0), a2, voffA);
            PG8_BAR; PG8_WAIT_L(0); PG8_MMA(1, 0, At, B0); PG8_BAR; PG8_SCHED;
            PG8_STAGE(PG8_SB(0, 1), b2 + hstep, voffB);
            PG8_WAIT_V(6); PG8_BAR; PG8_MMA(1, 1, At, B1); PG8_BAR;
            PG8_LDB(B0, 1, 0); PG8_SCHED; PG8_LDA(At, 1, 0); PG8_STAGE(PG8_SA(0, 1), a2 + hstep, voffA);
            PG8_WAIT_L(8); PG8_BAR; PG8_WAIT_L(0); PG8_MMA(0, 0, At, B0); PG8_BAR; PG8_SCHED;
            PG8_LDB(B1, 1, 1); PG8_STAGE(PG8_SB(1, 0), b3, voffB);
            PG8_BAR; PG8_WAIT_L(0); PG8_MMA(0, 1, At, B1); PG8_BAR;
            PG8_LDA(At, 1, 1); PG8_STAGE(PG8_SA(1, 0), a3, voffA);
            PG8_BAR; PG8_WAIT_L(0); PG8_MMA(1, 0, At, B0); PG8_BAR; PG8_SCHED;
            PG8_STAGE(PG8_SB(1, 1), b3 + hstep, voffB);
            PG8_WAIT_V(6); PG8_BAR; PG8_MMA(1, 1, At, B1); PG8_BAR;
        }
        PG8_STAMP();
        if constexpr (!Epi::AFTER_DRAIN) { E(acc, cur, wr, wc, fr, fq); S.done(cur); }
        PG8_STAMP();
        if (!has_next) break;
#pragma unroll
        for (int a = 0; a < 2; ++a)
#pragma unroll
            for (int b = 0; b < 2; ++b)
#pragma unroll
                for (int m = 0; m < 4; ++m)
#pragma unroll
                    for (int n = 0; n < 2; ++n) acc[a][b][m][n] = (f32x4){0.f, 0.f, 0.f, 0.f};
        cur = nxt; cA = nA; cB = nB; ++ui;
    }
    PG8_WAIT_V(0);
    if (wr == 0) PG8_BAR;
    PG8_BAR;
    if constexpr (Epi::AFTER_DRAIN) { E.fused(acc, cur, wr, wc, fr, fq, lds, wid, lane); S.done(cur); }
    PG8_STAMP();
    if (STAMP && wid == 0) { stamps[lane] = lane < nts ? (((unsigned long long)(unsigned)ts_hi << 32) | (unsigned)ts_lo) : 0ull;
        if (lane == 62) stamps[62] = rt_entry; if (lane == 63) stamps[63] = (unsigned long long)wall_clock64(); }
#undef PG8_STAMP
#undef PG8_SA
#undef PG8_SB
#undef PG8_STAGE
#undef PG8_LDA
#undef PG8_LDB
#undef PG8_MMA
#undef PG8_WAIT_V
#undef PG8_WAIT_L
#undef PG8_BAR
#undef PG8_SCHED
}
}

using namespace pg8;
#define LAS PG8_LAS
typedef unsigned u32x2 __attribute__((ext_vector_type(2)));
typedef float f32x2v __attribute__((ext_vector_type(2)));

constexpr int DM = 2048, SEQ = 4096, NTOK_P = 8192, NTOK = 8224, M_PAD = 8448, NIN = 5632, DFF = 5632, PLE = 256;
constexpr int ZC_AQ = 0, ZC_AK = 1024, ZC_AV = 1280, ZC_RQ = 1536, ZC_RK = 2560, ZC_RV = 3584, ZC_RG = 4608;
constexpr float EPS = 1e-6f;
constexpr float ATTN_SCALE = 0.08838834764831845f, RET_K_SCALE = 0.08838834764831845f;
constexpr size_t O_YP = 0, O_YS = 16777216, O_KWP = 16842752, O_VWP = 16908288, O_RSP = 16973824, O_KWS = 17235968, O_VWS = 18284544, O_RSS = 19333120;
constexpr size_t W_IN = 0;
constexpr size_t W_OUT = W_IN + (size_t)NIN * DM * 2;
constexpr size_t W_GU = W_OUT + (size_t)DM * DM * 2;
constexpr size_t W_DOWN = W_GU + (size_t)2 * DFF * DM * 2;
constexpr size_t W_PLE = W_DOWN + (size_t)DM * DFF * 2;
constexpr size_t W_PG = W_PLE + (size_t)DM * PLE * 2;
constexpr size_t BUF_A = W_PG + (size_t)DM * DM * 2;
constexpr size_t BUF_B = BUF_A + (size_t)M_PAD * DM * 2;
constexpr size_t BUF_Z = BUF_B + (size_t)M_PAD * DM * 2;
constexpr size_t BUF_P = BUF_Z + (size_t)M_PAD * NIN * 2;
constexpr size_t BUF_RS = BUF_P + (size_t)M_PAD * PLE * 2;
constexpr size_t BUF_ROPE = BUF_RS + (size_t)2 * M_PAD * 4;
constexpr size_t WS_END = BUF_ROPE + (size_t)2 * 4097 * 64 * 4;
constexpr int LDS_BYTES = 141312;

struct Params {
  const float *x_p, *x_s, *ck, *cv, *st, *p_p, *p_s, *an, *w_in, *qn, *kn, *sinks, *rg, *w_out, *fn, *w_gate, *w_up, *w_down, *pn, *w_ple, *w_pg;
  float* out; unsigned char* ws;
};

__device__ __forceinline__ float bf_lo(unsigned w) { return __uint_as_float(w << 16); }
__device__ __forceinline__ float bf_hi(unsigned w) { return __uint_as_float(w & 0xffff0000u); }
__device__ __forceinline__ float bf2f(bf16_t v) { return __uint_as_float(((unsigned)v) << 16); }
__device__ __forceinline__ void unpack8(const u32x4 w, float (&f)[8]) {
  f[0] = bf_lo(w.x); f[1] = bf_hi(w.x); f[2] = bf_lo(w.y); f[3] = bf_hi(w.y); f[4] = bf_lo(w.z); f[5] = bf_hi(w.z); f[6] = bf_lo(w.w); f[7] = bf_hi(w.w);
}
__device__ __forceinline__ u32x4 pack8(const float (&f)[8]) {
  u32x4 w; w.x = cvt_pk_bf16(f[0], f[1]); w.y = cvt_pk_bf16(f[2], f[3]); w.z = cvt_pk_bf16(f[4], f[5]); w.w = cvt_pk_bf16(f[6], f[7]); return w;
}
__device__ __forceinline__ unsigned half_of(const u32x4 w, int e) { const unsigned x = (e >> 1) == 0 ? w.x : (e >> 1) == 1 ? w.y : (e >> 1) == 2 ? w.z : w.w; return (e & 1) ? (x >> 16) : (x & 0xffffu); }
__device__ __forceinline__ float silu_f(float x) { return x / (1.0f + __expf(-x)); }
__device__ __forceinline__ float sigmoid_f(float x) { return 1.0f / (1.0f + __expf(-x)); }
__device__ __forceinline__ float wave_sum(float v) { for (int o = 32; o >= 1; o >>= 1) v += __shfl_xor(v, o); return v; }
__device__ __forceinline__ float wave_max(float v) { for (int o = 32; o >= 1; o >>= 1) v = fmaxf(v, __shfl_xor(v, o)); return v; }
__device__ __forceinline__ float ret_lg(int h) { return log1pf(-exp2f(-5.0f - (float)h)); }

struct EpiZ {
  static constexpr bool PERM = true, AFTER_DRAIN = false;
  bf16_t* O; int ldc;
  __device__ __forceinline__ void operator()(const f32x4 (&acc)[2][2][4][2], const Unit& u, int wr, int wc, int fr, int fq) const {
    const int row0 = u.pm * BM + wr * 64 + fr, col0 = u.pn * BM + wc * 32 + 8 * fq;
#pragma unroll
    for (int ai = 0; ai < 2; ++ai)
#pragma unroll
      for (int m = 0; m < 4; ++m) { bf16_t* rowp = O + (size_t)(row0 + ai * HALF + m * 16) * ldc + col0;
#pragma unroll
        for (int bj = 0; bj < 2; ++bj) { const f32x4 v0 = acc[ai][bj][m][0], v1 = acc[ai][bj][m][1];
          u32x4 w; w.x = cvt_pk_bf16(v0[0], v0[1]); w.y = cvt_pk_bf16(v0[2], v0[3]); w.z = cvt_pk_bf16(v1[0], v1[1]); w.w = cvt_pk_bf16(v1[2], v1[3]);
          *(u32x4*)(rowp + bj * HALF) = w; } }
  }
};
struct EpiRes {
  static constexpr bool PERM = true, AFTER_DRAIN = false;
  const float* res_p; const float* res_s; float* out; bf16_t* HG; const float* g; float* rs;
  __device__ __forceinline__ void operator()(const f32x4 (&acc)[2][2][4][2], const Unit& u, int wr, int wc, int fr, int fq) const {
    const int row0 = u.pm * BM + wr * 64 + fr, col0 = u.pn * BM + wc * 32 + 8 * fq;
    f32x4 gv[2][2];
#pragma unroll
    for (int bj = 0; bj < 2; ++bj) { gv[bj][0] = *(const f32x4*)(g + col0 + bj * HALF); gv[bj][1] = *(const f32x4*)(g + col0 + bj * HALF + 4); }
#pragma unroll
    for (int ai = 0; ai < 2; ++ai)
#pragma unroll
      for (int m = 0; m < 4; ++m) {
        const int row = row0 + ai * HALF + m * 16; const bool valid = row < NTOK;
        const float* rp = (row < NTOK_P ? res_p + (size_t)row * DM : res_s + (size_t)(row - NTOK_P) * DM) + col0;
        float* op = out + (size_t)row * DM + col0; bf16_t* hp = HG + (size_t)row * DM + col0;
        float ss = 0.f;
#pragma unroll
        for (int bj = 0; bj < 2; ++bj) {
          f32x4 v0 = acc[ai][bj][m][0], v1 = acc[ai][bj][m][1];
          if (valid) { v0 += *(const f32x4*)(rp + bj * HALF); v1 += *(const f32x4*)(rp + bj * HALF + 4);
            *(f32x4*)(op + bj * HALF) = v0; *(f32x4*)(op + bj * HALF + 4) = v1; }
          ss += v0[0] * v0[0] + v0[1] * v0[1] + v0[2] * v0[2] + v0[3] * v0[3] + v1[0] * v1[0] + v1[1] * v1[1] + v1[2] * v1[2] + v1[3] * v1[3];
          const f32x4 h0 = v0 * gv[bj][0], h1 = v1 * gv[bj][1];
          u32x4 w; w.x = cvt_pk_bf16(h0[0], h0[1]); w.y = cvt_pk_bf16(h0[2], h0[3]); w.z = cvt_pk_bf16(h1[0], h1[1]); w.w = cvt_pk_bf16(h1[2], h1[3]);
          *(u32x4*)(hp + bj * HALF) = w; }
        ss += __shfl_xor(ss, 16); ss += __shfl_xor(ss, 32);
        if (fq == 0 && valid) atomicAdd(rs + row, ss);
      }
  }
};
struct EpiAct {
  static constexpr bool PERM = true, AFTER_DRAIN = false;
  bf16_t* O; const float* rs;
  __device__ __forceinline__ void operator()(const f32x4 (&acc)[2][2][4][2], const Unit& u, int wr, int wc, int fr, int fq) const {
    const int row0 = u.pm * BM + wr * 64 + fr, col0 = u.pn * HALF + wc * 32 + 8 * fq;
#pragma unroll
    for (int ai = 0; ai < 2; ++ai)
#pragma unroll
      for (int m = 0; m < 4; ++m) {
        const int row = row0 + ai * HALF + m * 16;
        const float r = rsqrtf(rs[row] * (1.0f / DM) + EPS);
        float a[8];
#pragma unroll
        for (int n = 0; n < 2; ++n)
#pragma unroll
          for (int j = 0; j < 4; ++j) { const float gg = acc[ai][0][m][n][j] * r, uu = acc[ai][1][m][n][j] * r; a[n * 4 + j] = silu_f(gg) * uu; }
        *(u32x4*)(O + (size_t)row * DFF + col0) = pack8(a);
      }
  }
};
struct EpiPle {
  static constexpr bool PERM = true, AFTER_DRAIN = false;
  float* out; const bf16_t* T; const float* rs;
  __device__ __forceinline__ void operator()(const f32x4 (&acc)[2][2][4][2], const Unit& u, int wr, int wc, int fr, int fq) const {
    const int row0 = u.pm * BM + wr * 64 + fr, col0 = u.pn * BM + wc * 32 + 8 * fq;
#pragma unroll
    for (int ai = 0; ai < 2; ++ai)
#pragma unroll
      for (int m = 0; m < 4; ++m) {
        const int row = row0 + ai * HALF + m * 16;
        if (row < NTOK) {
          const float r = rsqrtf(rs[row] * (1.0f / DM) + EPS);
          float* op = out + (size_t)row * DM + col0; const bf16_t* tp = T + (size_t)row * DM + col0;
#pragma unroll
          for (int bj = 0; bj < 2; ++bj) {
            float t[8]; unpack8(*(const u32x4*)(tp + bj * HALF), t);
            f32x4 h0 = *(const f32x4*)(op + bj * HALF), h1 = *(const f32x4*)(op + bj * HALF + 4);
            const f32x4 a0 = acc[ai][bj][m][0], a1 = acc[ai][bj][m][1];
#pragma unroll
            for (int j = 0; j < 4; ++j) { h0[j] += t[j] * sigmoid_f(a0[j] * r); h1[j] += t[4 + j] * sigmoid_f(a1[j] * r); }
            *(f32x4*)(op + bj * HALF) = h0; *(f32x4*)(op + bj * HALF + 4) = h1; }
        }
      }
  }
};
__device__ __forceinline__ void transpose_tile(const float* __restrict__ src, int K, int N, bf16_t* __restrict__ dst, int rs, int off, int t, LAS float* tile) {
  const int tid = threadIdx.x, nnt = N >> 6, nt = t % nnt, kt = t / nnt, k0 = kt * 128, n0 = nt * 64;
  f32x4 v[4];
#pragma unroll
  for (int i = 0; i < 4; ++i) { const int r = (tid >> 4) + 32 * i, c4 = (tid & 15) * 4; v[i] = *(const f32x4*)(src + (size_t)(k0 + r) * N + n0 + c4); }
#pragma unroll
  for (int i = 0; i < 4; ++i) { const int r = (tid >> 4) + 32 * i, c4 = (tid & 15) * 4; LAS float* q = tile + r * 65 + c4; q[0] = v[i][0]; q[1] = v[i][1]; q[2] = v[i][2]; q[3] = v[i][3]; }
  __syncthreads();
  const int n = tid & 63, kb = (tid >> 6) * 16;
  float f[16];
#pragma unroll
  for (int j = 0; j < 16; ++j) f[j] = tile[(kb + j) * 65 + n];
  const int nn = n0 + n, drow = (nn >> 7) * rs + (nn & 127) + off;
  bf16_t* dp = dst + (size_t)drow * K + k0 + kb;
  u32x4 w0, w1;
  w0.x = cvt_pk_bf16(f[0], f[1]); w0.y = cvt_pk_bf16(f[2], f[3]); w0.z = cvt_pk_bf16(f[4], f[5]); w0.w = cvt_pk_bf16(f[6], f[7]);
  w1.x = cvt_pk_bf16(f[8], f[9]); w1.y = cvt_pk_bf16(f[10], f[11]); w1.z = cvt_pk_bf16(f[12], f[13]); w1.w = cvt_pk_bf16(f[14], f[15]);
  *(u32x4*)dp = w0; *(u32x4*)(dp + 8) = w1;
  __syncthreads();
}

__device__ __forceinline__ void phase_prep(const Params& p, LAS unsigned char* lds) {
  const int tid = threadIdx.x, wid = __builtin_amdgcn_readfirstlane(tid >> 6), lane = tid & 63;
  unsigned char* ws = p.ws;
  {
    constexpr int T_IN = (DM / 128) * (NIN / 64), T_OUT = (DM / 128) * (DM / 64), T_G = (DM / 128) * (DFF / 64), T_D = (DFF / 128) * (DM / 64), T_PL = (PLE / 128) * (DM / 64), T_PG = T_OUT;
    constexpr int S1 = T_IN, S2 = S1 + T_OUT, S3 = S2 + T_G, S4 = S3 + T_G, S5 = S4 + T_D, S6 = S5 + T_PL, S7 = S6 + T_PG;
    LAS float* tile = (LAS float*)lds;
    for (int g = blockIdx.x; g < S7; g += gridDim.x) {
      if (g < S1) transpose_tile(p.w_in, DM, NIN, (bf16_t*)(ws + W_IN), 128, 0, g, tile);
      else if (g < S2) transpose_tile(p.w_out, DM, DM, (bf16_t*)(ws + W_OUT), 128, 0, g - S1, tile);
      else if (g < S3) transpose_tile(p.w_gate, DM, DFF, (bf16_t*)(ws + W_GU), 256, 0, g - S2, tile);
      else if (g < S4) transpose_tile(p.w_up, DM, DFF, (bf16_t*)(ws + W_GU), 256, 128, g - S3, tile);
      else if (g < S5) transpose_tile(p.w_down, DFF, DM, (bf16_t*)(ws + W_DOWN), 128, 0, g - S4, tile);
      else if (g < S6) transpose_tile(p.w_ple, PLE, DM, (bf16_t*)(ws + W_PLE), 128, 0, g - S5, tile);
      else transpose_tile(p.w_pg, DM, DM, (bf16_t*)(ws + W_PG), 128, 0, g - S6, tile);
    }
  }
  {
    bf16_t* A0 = (bf16_t*)(ws + BUF_A);
    for (int row = blockIdx.x * 8 + wid; row < M_PAD; row += gridDim.x * 8) {
      bf16_t* dst = A0 + (size_t)row * DM;
      if (row >= NTOK) {
#pragma unroll
        for (int i = 0; i < 8; ++i) *(u32x2*)(dst + (i * 64 + lane) * 4) = (u32x2){0u, 0u};
        continue;
      }
      const float* src = row < NTOK_P ? p.x_p + (size_t)row * DM : p.x_s + (size_t)(row - NTOK_P) * DM;
      f32x4 v[8]; float ss = 0.f;
#pragma unroll
      for (int i = 0; i < 8; ++i) { v[i] = *(const f32x4*)(src + (i * 64 + lane) * 4); ss += v[i][0] * v[i][0] + v[i][1] * v[i][1] + v[i][2] * v[i][2] + v[i][3] * v[i][3]; }
      ss = wave_sum(ss);
      const float r = rsqrtf(ss * (1.0f / DM) + EPS);
#pragma unroll
      for (int i = 0; i < 8; ++i) { const f32x4 g = *(const f32x4*)(p.an + (i * 64 + lane) * 4); const f32x4 y = v[i] * r * g;
        *(u32x2*)(dst + (i * 64 + lane) * 4) = (u32x2){cvt_pk_bf16(y[0], y[1]), cvt_pk_bf16(y[2], y[3])}; }
    }
  }
  const size_t gtid = (size_t)blockIdx.x * 512 + tid, gstride = (size_t)gridDim.x * 512;
  {
    bf16_t* P = (bf16_t*)(ws + BUF_P);
    for (size_t i = gtid; i < (size_t)M_PAD * 64; i += gstride) {
      const int row = (int)(i >> 6), c4 = (int)(i & 63) * 4;
      f32x4 v = (f32x4){0.f, 0.f, 0.f, 0.f};
      if (row < NTOK_P) v = *(const f32x4*)(p.p_p + (size_t)row * PLE + c4); else if (row < NTOK) v = *(const f32x4*)(p.p_s + (size_t)(row - NTOK_P) * PLE + c4);
      *(u32x2*)(P + (size_t)row * PLE + c4) = (u32x2){cvt_pk_bf16(v[0], v[1]), cvt_pk_bf16(v[2], v[3])};
    }
  }
  { float* rs = (float*)(ws + BUF_RS); for (size_t i = gtid; i < (size_t)2 * M_PAD; i += gstride) rs[i] = 0.f; }
  {
    float* rc = (float*)(ws + BUF_ROPE); float* rsn = rc + 4097 * 64;
    for (size_t i = gtid; i < (size_t)4097 * 64; i += gstride) {
      const int e = (int)(i >> 6), j = (int)(i & 63);
      const float pos = e < 4096 ? (float)e : 16384.0f;
      const float inv = (float)exp2(-(double)j * (13.287712379549449 / 64.0));
      const float ang = pos * inv;
      const double rev = (double)ang * 0.15915494309189535; const float fr = (float)(rev - floor(rev));
      rc[i] = __builtin_amdgcn_cosf(fr); rsn[i] = __builtin_amdgcn_sinf(fr);
    }
  }
}

#define MFMA16(a, b, c) __builtin_amdgcn_mfma_f32_16x16x32_bf16((a), (b), (c), 0, 0, 0)
constexpr int LDR = 272;

__device__ __forceinline__ void rot16(const bf16_t* zrow, int cc, const float* rc, const float* rsn, int pos_entry, float sc, float (&o1)[8], float (&o2)[8]) {
  float x1[8], x2[8]; unpack8(*(const u32x4*)(zrow + cc * 8), x1); unpack8(*(const u32x4*)(zrow + 64 + cc * 8), x2);
  const f32x4 c0 = *(const f32x4*)(rc + pos_entry * 64 + cc * 8), c1 = *(const f32x4*)(rc + pos_entry * 64 + cc * 8 + 4);
  const f32x4 s0 = *(const f32x4*)(rsn + pos_entry * 64 + cc * 8), s1 = *(const f32x4*)(rsn + pos_entry * 64 + cc * 8 + 4);
#pragma unroll
  for (int e = 0; e < 8; ++e) { const float cs = e < 4 ? c0[e & 3] : c1[e & 3], sn = e < 4 ? s0[e & 3] : s1[e & 3];
    o1[e] = (x1[e] * cs - x2[e] * sn) * sc; o2[e] = (x1[e] * sn + x2[e] * cs) * sc; }
}

__device__ __forceinline__ void attn_item(const Params& p, LAS unsigned char* lds, int item) {
  constexpr int K_OFF = 0, V_OFF = 256 * LDR, VLD = 560, PLD = 336, PWAVE = 16 * PLD;
  const int tid = threadIdx.x, wid = __builtin_amdgcn_readfirstlane(tid >> 6), lane = tid & 63, fr = lane & 15, fq = lane >> 4;
  const int b = item >> 8, blk = (item >> 3) & 31, h = item & 7, kvh = h >> 2;
  const bf16_t* Z = (const bf16_t*)(p.ws + BUF_Z);
  bf16_t* MIX = (bf16_t*)(p.ws + BUF_A);
  const int tok0 = b * SEQ + blk * 128;
  bf16x8 Qa[4];
  {
    const bf16_t* qp = Z + (size_t)(tok0 + wid * 16 + fr) * NIN + ZC_AQ + h * 128 + fq * 8;
    float qf[4][8]; float ss = 0.f;
#pragma unroll
    for (int ks = 0; ks < 4; ++ks) { unpack8(*(const u32x4*)(qp + ks * 32), qf[ks]);
#pragma unroll
      for (int e = 0; e < 8; ++e) ss += qf[ks][e] * qf[ks][e]; }
    ss += __shfl_xor(ss, 16); ss += __shfl_xor(ss, 32);
    const float r = rsqrtf(ss * (1.0f / 128.0f) + EPS);
#pragma unroll
    for (int ks = 0; ks < 4; ++ks) { const f32x4 g0 = *(const f32x4*)(p.qn + ks * 32 + fq * 8), g1 = *(const f32x4*)(p.qn + ks * 32 + fq * 8 + 4);
      float y[8];
#pragma unroll
      for (int e = 0; e < 8; ++e) y[e] = qf[ks][e] * r * (e < 4 ? g0[e & 3] : g1[e & 3]);
      const u32x4 w = pack8(y); Qa[ks] = *(const bf16x8*)&w; }
  }
  const bool write_win = (blk == 31) && ((h & 3) == 0);
  {
    const int c = tid & 15; const f32x4 g0 = *(const f32x4*)(p.kn + c * 8), g1 = *(const f32x4*)(p.kn + c * 8 + 4);
#pragma unroll
    for (int i = 0; i < 8; ++i) {
      const int row = (tid >> 4) + 32 * i, kpos = (blk - 1) * 128 + row;
      u32x4 raw = (u32x4){0u, 0u, 0u, 0u};
      if (kpos >= 0) raw = *(const u32x4*)(Z + (size_t)(b * SEQ + kpos) * NIN + ZC_AK + kvh * 128 + c * 8);
      float f[8]; unpack8(raw, f); float ss = 0.f;
#pragma unroll
      for (int e = 0; e < 8; ++e) ss += f[e] * f[e];
      ss += __shfl_xor(ss, 1); ss += __shfl_xor(ss, 2); ss += __shfl_xor(ss, 4); ss += __shfl_xor(ss, 8);
      const float r = rsqrtf(ss * (1.0f / 128.0f) + EPS);
#pragma unroll
      for (int e = 0; e < 8; ++e) f[e] = f[e] * r * (e < 4 ? g0[e & 3] : g1[e & 3]);
      *(LAS u32x4*)(lds + K_OFF + row * LDR + c * 16) = pack8(f);
      if (write_win && row >= 128) { float* kw = p.out + O_KWP + ((size_t)(b * 128 + row - 128) * 2 + kvh) * 128 + c * 8;
        *(f32x4*)kw = (f32x4){f[0], f[1], f[2], f[3]}; *(f32x4*)(kw + 4) = (f32x4){f[4], f[5], f[6], f[7]}; }
    }
  }
  {
    const int c = tid & 15;
#pragma unroll
    for (int i = 0; i < 4; ++i) {
      const int kp = (tid >> 4) + 32 * i, j0 = 2 * kp, kpos = (blk - 1) * 128 + j0;
      u32x4 r0 = (u32x4){0u, 0u, 0u, 0u}, r1 = r0;
      if (kpos >= 0) { const bf16_t* vp = Z + (size_t)(b * SEQ + kpos) * NIN + ZC_AV + kvh * 128 + c * 8; r0 = *(const u32x4*)vp; r1 = *(const u32x4*)(vp + NIN); }
#pragma unroll
      for (int e = 0; e < 8; ++e) *(LAS unsigned*)(lds + V_OFF + (c * 8 + e) * VLD + kp * 4) = half_of(r0, e) | (half_of(r1, e) << 16);
      if (write_win && j0 >= 128) { float f0[8], f1[8]; unpack8(r0, f0); unpack8(r1, f1);
        float* vw = p.out + O_VWP + ((size_t)(b * 128 + j0 - 128) * 2 + kvh) * 128 + c * 8;
        *(f32x4*)vw = (f32x4){f0[0], f0[1], f0[2], f0[3]}; *(f32x4*)(vw + 4) = (f32x4){f0[4], f0[5], f0[6], f0[7]};
        *(f32x4*)(vw + 256) = (f32x4){f1[0], f1[1], f1[2], f1[3]}; *(f32x4*)(vw + 260) = (f32x4){f1[4], f1[5], f1[6], f1[7]}; }
    }
    if (tid < 256) *(LAS u32x4*)(lds + V_OFF + (tid >> 1) * VLD + 512 + (tid & 1) * 16) = (u32x4){0u, 0u, 0u, 0u};
  }
  __syncthreads();
  f32x4 S[9];
#pragma unroll
  for (int tt = 0; tt < 9; ++tt) S[tt] = (f32x4){0.f, 0.f, 0.f, 0.f};
#pragma unroll
  for (int ks = 0; ks < 4; ++ks)
#pragma unroll
    for (int tt = 0; tt < 9; ++tt) { const bf16x8 kb = *(const LAS bf16x8*)(lds + K_OFF + ((wid + tt) * 16 + fr) * LDR + (ks * 32 + fq * 8) * 2); S[tt] = MFMA16(kb, Qa[ks], S[tt]); }
  const int qi = wid * 16 + fr; const float sink = p.sinks[h];
  float mx = sink;
#pragma unroll
  for (int tt = 0; tt < 9; ++tt)
#pragma unroll
    for (int jj = 0; jj < 4; ++jj) { const int j = (wid + tt) * 16 + fq * 4 + jj; const bool valid = (j >= qi) && (j <= qi + 128) && (blk > 0 || j >= 128);
      const float s = valid ? S[tt][jj] * ATTN_SCALE : -INFINITY; S[tt][jj] = s; mx = fmaxf(mx, s); }
  mx = fmaxf(mx, __shfl_xor(mx, 16)); mx = fmaxf(mx, __shfl_xor(mx, 32));
  float sum = 0.f;
#pragma unroll
  for (int tt = 0; tt < 9; ++tt)
#pragma unroll
    for (int jj = 0; jj < 4; ++jj) { const float e = __expf(S[tt][jj] - mx); S[tt][jj] = e; sum += e; }
  sum += __shfl_xor(sum, 16); sum += __shfl_xor(sum, 32);
  const float inv = 1.0f / (sum + __expf(sink - mx));
  __syncthreads();
  LAS unsigned char* Pw = lds + K_OFF + wid * PWAVE;
#pragma unroll
  for (int tt = 0; tt < 9; ++tt) *(LAS u32x2*)(Pw + fr * PLD + (tt * 16 + fq * 4) * 2) = (u32x2){cvt_pk_bf16(S[tt][0] * inv, S[tt][1] * inv), cvt_pk_bf16(S[tt][2] * inv, S[tt][3] * inv)};
  *(LAS u32x2*)(Pw + fr * PLD + (9 * 16 + fq * 4) * 2) = (u32x2){0u, 0u};
  __syncthreads();
  f32x4 O[8];
#pragma unroll
  for (int nt = 0; nt < 8; ++nt) O[nt] = (f32x4){0.f, 0.f, 0.f, 0.f};
#pragma unroll
  for (int ks = 0; ks < 5; ++ks) { const bf16x8 pa = *(const LAS bf16x8*)(Pw + fr * PLD + (ks * 32 + fq * 8) * 2);
#pragma unroll
    for (int nt = 0; nt < 8; ++nt) { const bf16x8 vb = *(const LAS bf16x8*)(lds + V_OFF + (nt * 16 + fr) * VLD + (wid * 16 + ks * 32 + fq * 8) * 2); O[nt] = MFMA16(vb, pa, O[nt]); } }
  bf16_t* op = MIX + (size_t)(tok0 + qi) * DM + h * 128 + fq * 4;
#pragma unroll
  for (int nt = 0; nt < 8; ++nt) *(u32x2*)(op + nt * 16) = (u32x2){cvt_pk_bf16(O[nt][0], O[nt][1]), cvt_pk_bf16(O[nt][2], O[nt][3])};
  __syncthreads();
}

__device__ __forceinline__ void stage_vt128(const bf16_t* Z, int tok0, int col, LAS unsigned char* dst) {
  const int tid = threadIdx.x, c = tid & 15;
#pragma unroll
  for (int i = 0; i < 2; ++i) { const int kp = (tid >> 4) + 32 * i; const bf16_t* vp = Z + (size_t)(tok0 + 2 * kp) * NIN + col + c * 8;
    const u32x4 r0 = *(const u32x4*)vp, r1 = *(const u32x4*)(vp + NIN);
#pragma unroll
    for (int e = 0; e < 8; ++e) *(LAS unsigned*)(dst + (c * 8 + e) * LDR + kp * 4) = half_of(r0, e) | (half_of(r1, e) << 16); }
}
__device__ __forceinline__ void retkv_item(const Params& p, LAS unsigned char* lds, int item) {
  constexpr int KT_OFF = 0, VT_OFF = 128 * LDR;
  const int tid = threadIdx.x, wid = __builtin_amdgcn_readfirstlane(tid >> 6), lane = tid & 63, fr = lane & 15, fq = lane >> 4;
  const int bh = item >> 5, c = item & 31, b = bh >> 3, h = bh & 7;
  const bf16_t* Z = (const bf16_t*)(p.ws + BUF_Z);
  const float* rc = (const float*)(p.ws + BUF_ROPE); const float* rsn = rc + 4097 * 64;
  float* KV = (float*)(p.ws + BUF_B);
  const int tok0 = b * SEQ + c * 128; const float lg = ret_lg(h);
  {
    const int cc = tid & 7, kp = tid >> 3, n0 = 2 * kp;
    float a1[8], a2[8], b1[8], b2[8];
    rot16(Z + (size_t)(tok0 + n0) * NIN + ZC_RK + h * 128, cc, rc, rsn, c * 128 + n0, RET_K_SCALE * __expf(lg * (float)(127 - n0)), a1, a2);
    rot16(Z + (size_t)(tok0 + n0 + 1) * NIN + ZC_RK + h * 128, cc, rc, rsn, c * 128 + n0 + 1, RET_K_SCALE * __expf(lg * (float)(126 - n0)), b1, b2);
#pragma unroll
    for (int e = 0; e < 8; ++e) { *(LAS unsigned*)(lds + KT_OFF + (cc * 8 + e) * LDR + kp * 4) = cvt_pk_bf16(a1[e], b1[e]);
      *(LAS unsigned*)(lds + KT_OFF + (64 + cc * 8 + e) * LDR + kp * 4) = cvt_pk_bf16(a2[e], b2[e]); }
  }
  stage_vt128(Z, tok0, ZC_RV + h * 128, lds + VT_OFF);
  __syncthreads();
  f32x4 acc[8];
#pragma unroll
  for (int nt = 0; nt < 8; ++nt) acc[nt] = (f32x4){0.f, 0.f, 0.f, 0.f};
#pragma unroll
  for (int ks = 0; ks < 4; ++ks) { const bf16x8 a = *(const LAS bf16x8*)(lds + KT_OFF + (wid * 16 + fr) * LDR + (ks * 32 + fq * 8) * 2);
#pragma unroll
    for (int nt = 0; nt < 8; ++nt) { const bf16x8 vb = *(const LAS bf16x8*)(lds + VT_OFF + (nt * 16 + fr) * LDR + (ks * 32 + fq * 8) * 2); acc[nt] = MFMA16(vb, a, acc[nt]); } }
  float* kvp = KV + (size_t)item * 16384 + (wid * 16 + fr) * 128 + fq * 4;
#pragma unroll
  for (int nt = 0; nt < 8; ++nt) *(f32x4*)(kvp + nt * 16) = acc[nt];
  __syncthreads();
}

__device__ __forceinline__ void phase_scan(const Params& p) {
  f32x2v* KV = (f32x2v*)(p.ws + BUF_B);
  const size_t gtid = (size_t)blockIdx.x * 512 + threadIdx.x, gstride = (size_t)gridDim.x * 512;
  for (size_t idx = gtid; idx < (size_t)16 * 8192; idx += gstride) {
    const int bh = (int)(idx >> 13), e2 = (int)(idx & 8191), h = bh & 7;
    const float dec = __expf(ret_lg(h) * 128.0f);
    f32x2v* base = KV + (size_t)bh * 32 * 8192 + e2;
    f32x2v v[32];
#pragma unroll
    for (int c = 0; c < 32; ++c) v[c] = base[(size_t)c * 8192];
    f32x2v s = (f32x2v){0.f, 0.f};
#pragma unroll
    for (int c = 0; c < 32; ++c) { base[(size_t)c * 8192] = s; s = s * dec + v[c]; }
    *(f32x2v*)(p.out + O_RSP + (size_t)bh * 16384 + e2 * 2) = s;
  }
}

__device__ __forceinline__ void retout_item(const Params& p, LAS unsigned char* lds, int item) {
  constexpr int Q_OFF = 0, K_OFF = 128 * LDR, VT_OFF = 256 * LDR, ST_OFF = 384 * LDR;
  const int tid = threadIdx.x, wid = __builtin_amdgcn_readfirstlane(tid >> 6), lane = tid & 63, fr = lane & 15, fq = lane >> 4;
  const int bh = item >> 5, c = item & 31, b = bh >> 3, h = bh & 7;
  const bf16_t* Z = (const bf16_t*)(p.ws + BUF_Z);
  bf16_t* MIX = (bf16_t*)(p.ws + BUF_A);
  const float* rc = (const float*)(p.ws + BUF_ROPE); const float* rsn = rc + 4097 * 64;
  const float* SP = (const float*)(p.ws + BUF_B) + (size_t)item * 16384;
  const int tok0 = b * SEQ + c * 128; const float lg = ret_lg(h);
  {
    const int cc = tid & 7;
#pragma unroll
    for (int i = 0; i < 2; ++i) { const int n = (tid >> 3) + 64 * i; float o1[8], o2[8];
      rot16(Z + (size_t)(tok0 + n) * NIN + ZC_RQ + h * 128, cc, rc, rsn, c * 128 + n, 1.0f, o1, o2);
      *(LAS u32x4*)(lds + Q_OFF + n * LDR + cc * 16) = pack8(o1); *(LAS u32x4*)(lds + Q_OFF + n * LDR + (cc + 8) * 16) = pack8(o2);
      rot16(Z + (size_t)(tok0 + n) * NIN + ZC_RK + h * 128, cc, rc, rsn, c * 128 + n, RET_K_SCALE, o1, o2);
      *(LAS u32x4*)(lds + K_OFF + n * LDR + cc * 16) = pack8(o1); *(LAS u32x4*)(lds + K_OFF + n * LDR + (cc + 8) * 16) = pack8(o2); }
  }
  stage_vt128(Z, tok0, ZC_RV + h * 128, lds + VT_OFF);
  {
    const int c16 = tid & 15;
#pragma unroll
    for (int i = 0; i < 2; ++i) { const int kp = (tid >> 4) + 32 * i; const float* sp = SP + (size_t)(2 * kp) * 128 + c16 * 8;
      const f32x4 a0 = *(const f32x4*)sp, a1 = *(const f32x4*)(sp + 4), b0 = *(const f32x4*)(sp + 128), b1 = *(const f32x4*)(sp + 132);
#pragma unroll
      for (int e = 0; e < 8; ++e) *(LAS unsigned*)(lds + ST_OFF + (c16 * 8 + e) * LDR + kp * 4) = cvt_pk_bf16(e < 4 ? a0[e & 3] : a1[e & 3], e < 4 ? b0[e & 3] : b1[e & 3]); }
  }
  __syncthreads();
  const int n = wid * 16 + fr;
  bf16x8 Qa[4];
#pragma unroll
  for (int ks = 0; ks < 4; ++ks) Qa[ks] = *(const LAS bf16x8*)(lds + Q_OFF + n * LDR + (ks * 32 + fq * 8) * 2);
  f32x4 O[8];
#pragma unroll
  for (int nt = 0; nt < 8; ++nt) O[nt] = (f32x4){0.f, 0.f, 0.f, 0.f};
#pragma unroll
  for (int ks = 0; ks < 4; ++ks)
#pragma unroll
    for (int nt = 0; nt < 8; ++nt) { const bf16x8 sb = *(const LAS bf16x8*)(lds + ST_OFF + (nt * 16 + fr) * LDR + (ks * 32 + fq * 8) * 2); O[nt] = MFMA16(sb, Qa[ks], O[nt]); }
  const float qdec = __expf(lg * (float)(n + 1));
#pragma unroll
  for (int nt = 0; nt < 8; ++nt) O[nt] *= qdec;
  f32x4 SC[8];
#pragma unroll
  for (int tt = 0; tt < 8; ++tt) { SC[tt] = (f32x4){0.f, 0.f, 0.f, 0.f};
    if (tt <= wid) {
#pragma unroll
      for (int ks = 0; ks < 4; ++ks) { const bf16x8 kb = *(const LAS bf16x8*)(lds + K_OFF + (tt * 16 + fr) * LDR + (ks * 32 + fq * 8) * 2); SC[tt] = MFMA16(kb, Qa[ks], SC[tt]); } } }
  __syncthreads();
#pragma unroll
  for (int tt = 0; tt < 8; ++tt) { float pv[4];
#pragma unroll
    for (int jj = 0; jj < 4; ++jj) { const int e = tt * 16 + fq * 4 + jj; pv[jj] = (e <= n) ? SC[tt][jj] * __expf(lg * (float)(n - e)) : 0.f; }
    *(LAS u32x2*)(lds + K_OFF + n * LDR + (tt * 16 + fq * 4) * 2) = (u32x2){cvt_pk_bf16(pv[0], pv[1]), cvt_pk_bf16(pv[2], pv[3])}; }
  __syncthreads();
#pragma unroll
  for (int ks = 0; ks < 4; ++ks) { const bf16x8 pa = *(const LAS bf16x8*)(lds + K_OFF + n * LDR + (ks * 32 + fq * 8) * 2);
#pragma unroll
    for (int nt = 0; nt < 8; ++nt) { const bf16x8 vb = *(const LAS bf16x8*)(lds + VT_OFF + (nt * 16 + fr) * LDR + (ks * 32 + fq * 8) * 2); O[nt] = MFMA16(vb, pa, O[nt]); } }
  float ss = 0.f;
#pragma unroll
  for (int nt = 0; nt < 8; ++nt) ss += O[nt][0] * O[nt][0] + O[nt][1] * O[nt][1] + O[nt][2] * O[nt][2] + O[nt][3] * O[nt][3];
  ss += __shfl_xor(ss, 16); ss += __shfl_xor(ss, 32);
  const float r = rsqrtf(ss * (1.0f / 128.0f) + EPS);
  const bf16_t* gp = Z + (size_t)(tok0 + n) * NIN + ZC_RG + h * 128 + fq * 4;
  bf16_t* op = MIX + (size_t)(tok0 + n) * DM + 1024 + h * 128 + fq * 4;
#pragma unroll
  for (int nt = 0; nt < 8; ++nt) { const u32x2 gw = *(const u32x2*)(gp + nt * 16); const f32x4 rg = *(const f32x4*)(p.rg + h * 128 + nt * 16 + fq * 4);
    const float y0 = O[nt][0] * r * rg[0] * silu_f(bf_lo(gw.x)), y1 = O[nt][1] * r * rg[1] * silu_f(bf_hi(gw.x)), y2 = O[nt][2] * r * rg[2] * silu_f(bf_lo(gw.y)), y3 = O[nt][3] * r * rg[3] * silu_f(bf_hi(gw.y));
    *(u32x2*)(op + nt * 16) = (u32x2){cvt_pk_bf16(y0, y1), cvt_pk_bf16(y2, y3)}; }
  __syncthreads();
}
__device__ __forceinline__ void sample_item(const Params& p, LAS unsigned char* lds, int item) {
  const int tid = threadIdx.x, wid = __builtin_amdgcn_readfirstlane(tid >> 6), lane = tid & 63;
  const int b = item >> 3, h = item & 7, kvh = h >> 2, R = NTOK_P + b;
  const bf16_t* zr = (const bf16_t*)(p.ws + BUF_Z) + (size_t)R * NIN;
  bf16_t* mixr = (bf16_t*)(p.ws + BUF_A) + (size_t)R * DM;
  LAS float* qs = (LAS float*)lds; LAS float* ks = qs + 128; LAS float* vs = qs + 256; LAS float* sc = qs + 384; LAS float* pr = qs + 528; LAS float* part = qs + 672;
  LAS float* qr = qs + 2720; LAS float* kr = qr + 128; LAS float* vv = qr + 256; LAS float* gg = qr + 384;
  const float* rc = (const float*)(p.ws + BUF_ROPE) + 4096 * 64; const float* rsn = rc + 4097 * 64;
  if (wid == 0) { const float a0 = bf2f(zr[ZC_AQ + h * 128 + lane]), a1 = bf2f(zr[ZC_AQ + h * 128 + lane + 64]); const float r = rsqrtf(wave_sum(a0 * a0 + a1 * a1) * (1.0f / 128.0f) + EPS);
    qs[lane] = a0 * r * p.qn[lane]; qs[lane + 64] = a1 * r * p.qn[lane + 64]; }
  else if (wid == 1) { const float a0 = bf2f(zr[ZC_AK + kvh * 128 + lane]), a1 = bf2f(zr[ZC_AK + kvh * 128 + lane + 64]); const float r = rsqrtf(wave_sum(a0 * a0 + a1 * a1) * (1.0f / 128.0f) + EPS);
    ks[lane] = a0 * r * p.kn[lane]; ks[lane + 64] = a1 * r * p.kn[lane + 64]; }
  else if (wid == 2) { vs[lane] = bf2f(zr[ZC_AV + kvh * 128 + lane]); vs[lane + 64] = bf2f(zr[ZC_AV + kvh * 128 + lane + 64]); }
  else if (wid == 3) { const float x1 = bf2f(zr[ZC_RQ + h * 128 + lane]), x2 = bf2f(zr[ZC_RQ + h * 128 + lane + 64]); const float cs = rc[lane], sn = rsn[lane];
    qr[lane] = x1 * cs - x2 * sn; qr[lane + 64] = x1 * sn + x2 * cs; }
  else if (wid == 4) { const float x1 = bf2f(zr[ZC_RK + h * 128 + lane]), x2 = bf2f(zr[ZC_RK + h * 128 + lane + 64]); const float cs = rc[lane], sn = rsn[lane];
    kr[lane] = (x1 * cs - x2 * sn) * RET_K_SCALE; kr[lane + 64] = (x1 * sn + x2 * cs) * RET_K_SCALE; }
  else if (wid == 5) { vv[lane] = bf2f(zr[ZC_RV + h * 128 + lane]); vv[lane + 64] = bf2f(zr[ZC_RV + h * 128 + lane + 64]); }
  else if (wid == 6) { gg[lane] = bf2f(zr[ZC_RG + h * 128 + lane]); gg[lane + 64] = bf2f(zr[ZC_RG + h * 128 + lane + 64]); }
  __syncthreads();
  {
    const int j = tid >> 2, pt = tid & 3; const float* kp = p.ck + ((size_t)(b * 128 + j) * 2 + kvh) * 128 + pt * 32;
    float d = 0.f;
#pragma unroll
    for (int i = 0; i < 8; ++i) { const f32x4 kvv = *(const f32x4*)(kp + i * 4); d += kvv[0] * qs[pt * 32 + i * 4] + kvv[1] * qs[pt * 32 + i * 4 + 1] + kvv[2] * qs[pt * 32 + i * 4 + 2] + kvv[3] * qs[pt * 32 + i * 4 + 3]; }
    d += __shfl_xor(d, 1); d += __shfl_xor(d, 2);
    if (pt == 0) sc[j] = d * ATTN_SCALE;
    if (wid == 0) { const float dn = wave_sum(qs[lane] * ks[lane] + qs[lane + 64] * ks[lane + 64]); if (lane == 0) sc[128] = dn * ATTN_SCALE; }
  }
  __syncthreads();
  if (wid == 0) { const float sink = p.sinks[h]; const float s0 = sc[lane], s1 = sc[lane + 64], s2 = lane == 0 ? sc[128] : -INFINITY;
    const float mx = fmaxf(wave_max(fmaxf(fmaxf(s0, s1), s2)), sink);
    const float e0 = __expf(s0 - mx), e1 = __expf(s1 - mx), e2 = __expf(s2 - mx);
    const float inv = 1.0f / (wave_sum(e0 + e1 + e2) + __expf(sink - mx));
    pr[lane] = e0 * inv; pr[lane + 64] = e1 * inv; if (lane == 0) pr[128] = e2 * inv; }
  __syncthreads();
  {
    const int d = tid & 127, pt = tid >> 7; const float* vp = p.cv + ((size_t)(b * 128 + pt * 32) * 2 + kvh) * 128 + d;
    float a = 0.f;
#pragma unroll 8
    for (int j = 0; j < 32; ++j) a += pr[pt * 32 + j] * vp[(size_t)j * 256];
    if (pt == 0) a += pr[128] * vs[d];
    part[pt * 128 + d] = a;
  }
  __syncthreads();
  if (tid < 128) { const float o = part[tid] + part[128 + tid] + part[256 + tid] + part[384 + tid]; mixr[h * 128 + tid] = (bf16_t)(cvt_pk_bf16(o, 0.f) & 0xffffu); }
  if ((h & 3) == 0) {
    for (int idx = tid; idx < 128 * 128; idx += 512) { const int w = idx >> 7, d = idx & 127;
      const size_t src = ((size_t)(b * 128 + w + 1) * 2 + kvh) * 128 + d, dst = ((size_t)(b * 128 + w) * 2 + kvh) * 128 + d;
      p.out[O_KWS + dst] = w < 127 ? p.ck[src] : ks[d]; p.out[O_VWS + dst] = w < 127 ? p.cv[src] : vs[d]; }
  }
  __syncthreads();
  {
    const float gamma = 1.0f - exp2f(-5.0f - (float)h);
    const int dv4 = (tid & 31) * 4, dkg = tid >> 5;
    const f32x4 v4 = (f32x4){vv[dv4], vv[dv4 + 1], vv[dv4 + 2], vv[dv4 + 3]};
    f32x4 o4 = (f32x4){0.f, 0.f, 0.f, 0.f};
#pragma unroll
    for (int i = 0; i < 8; ++i) { const int dk = dkg + 16 * i; const size_t off = ((size_t)(b * 8 + h) * 128 + dk) * 128 + dv4;
      const f32x4 sn = *(const f32x4*)(p.st + off) * gamma + v4 * kr[dk];
      *(f32x4*)(p.out + O_RSS + off) = sn; o4 += sn * qr[dk]; }
    part[dkg * 128 + dv4] = o4[0]; part[dkg * 128 + dv4 + 1] = o4[1]; part[dkg * 128 + dv4 + 2] = o4[2]; part[dkg * 128 + dv4 + 3] = o4[3];
  }
  __syncthreads();
  if (wid == 0) { float o0 = 0.f, o1 = 0.f;
#pragma unroll
    for (int g = 0; g < 16; ++g) { o0 += part[g * 128 + lane]; o1 += part[g * 128 + lane + 64]; }
    const float r = rsqrtf(wave_sum(o0 * o0 + o1 * o1) * (1.0f / 128.0f) + EPS);
    const float y0 = o0 * r * p.rg[h * 128 + lane] * silu_f(gg[lane]), y1 = o1 * r * p.rg[h * 128 + lane + 64] * silu_f(gg[lane + 64]);
    mixr[1024 + h * 128 + lane] = (bf16_t)(cvt_pk_bf16(y0, 0.f) & 0xffffu); mixr[1024 + h * 128 + lane + 64] = (bf16_t)(cvt_pk_bf16(y1, 0.f) & 0xffffu); }
  __syncthreads();
}

__global__ void __launch_bounds__(512, 2) hybrid_fwd(Params p) {
  extern __shared__ __attribute__((aligned(16))) unsigned char shm[];
  cg::grid_group grid = cg::this_grid();
  LAS unsigned char* lds = (LAS unsigned char*)shm;
  unsigned char* ws = p.ws;
  const int G = (int)gridDim.x, bid = (int)blockIdx.x;
  bf16_t* bufA = (bf16_t*)(ws + BUF_A); bf16_t* bufB = (bf16_t*)(ws + BUF_B); bf16_t* bufZ = (bf16_t*)(ws + BUF_Z);
  float* rs1 = (float*)(ws + BUF_RS); float* rs2 = rs1 + M_PAD;

  phase_prep(p, lds);
  grid.sync();
  { Gemm g{bufA, (const bf16_t*)(ws + W_IN), M_PAD, NIN, DM}; StaticOrder S; S.init(M_PAD, NIN, G, bid); EpiZ E{bufZ, NIN};
    gemm_phase<EpiZ, StaticOrder, false>(lds, g, S, E, nullptr); }
  grid.sync();
  for (int it = bid; it < 1280; it += G) { if (it < 512) attn_item(p, lds, it); else if (it < 1024) retkv_item(p, lds, it - 512); else sample_item(p, lds, it - 1024); }
  grid.sync();
  phase_scan(p);
  grid.sync();
  for (int it = bid; it < 512; it += G) retout_item(p, lds, it);
  grid.sync();
  { Gemm g{bufA, (const bf16_t*)(ws + W_OUT), M_PAD, DM, DM}; StaticOrder S; S.init(M_PAD, DM, G, bid); EpiRes E{p.x_p, p.x_s, p.out, bufB, p.fn, rs1};
    gemm_phase<EpiRes, StaticOrder, false>(lds, g, S, E, nullptr); }
  grid.sync();
  { Gemm g{bufB, (const bf16_t*)(ws + W_GU), M_PAD, 2 * DFF, DM}; StaticOrder S; S.init(M_PAD, 2 * DFF, G, bid); EpiAct E{bufZ, rs1};
    gemm_phase<EpiAct, StaticOrder, false>(lds, g, S, E, nullptr); }
  grid.sync();
  { Gemm g{bufZ, (const bf16_t*)(ws + W_DOWN), M_PAD, DM, DFF}; StaticOrder S; S.init(M_PAD, DM, G, bid); EpiRes E{p.out, p.out + (size_t)NTOK_P * DM, p.out, bufA, p.pn, rs2};
    gemm_phase<EpiRes, StaticOrder, false>(lds, g, S, E, nullptr); }
  { Gemm g{(const bf16_t*)(ws + BUF_P), (const bf16_t*)(ws + W_PLE), M_PAD, DM, PLE}; StaticOrder S; S.init(M_PAD, DM, G, bid); EpiZ E{bufB, DM};
    gemm_phase<EpiZ, StaticOrder, false>(lds, g, S, E, nullptr); }
  grid.sync();
  { Gemm g{bufA, (const bf16_t*)(ws + W_PG), M_PAD, DM, DM}; StaticOrder S; S.init(M_PAD, DM, G, bid); EpiPle E{p.out, bufB, rs2};
    gemm_phase<EpiPle, StaticOrder, false>(lds, g, S, E, nullptr); }
}

extern "C" void kernel_launch(void* const* d_in, const int* in_sizes, int n_in, void* d_out, int out_size, void* d_ws, size_t ws_size, hipStream_t stream) {
  static int grid_blocks = 0;
  if (!grid_blocks) {
    int dev = 0, cus = 0, per_cu = 0;
    (void)hipGetDevice(&dev);
    (void)hipDeviceGetAttribute(&cus, hipDeviceAttributeMultiprocessorCount, dev);
    (void)hipFuncSetAttribute((const void*)hybrid_fwd, hipFuncAttributeMaxDynamicSharedMemorySize, LDS_BYTES);
    (void)hipOccupancyMaxActiveBlocksPerMultiprocessor(&per_cu, hybrid_fwd, 512, (size_t)LDS_BYTES);
    if (per_cu < 1) per_cu = 1;
    grid_blocks = cus * per_cu;
    if (ws_size < WS_END) fprintf(stderr, "workspace too small: %zu < %zu\n", ws_size, (size_t)WS_END);
  }
  Params p{};
  p.x_p = (const float*)d_in[0]; p.x_s = (const float*)d_in[1]; p.ck = (const float*)d_in[2]; p.cv = (const float*)d_in[3]; p.st = (const float*)d_in[4];
  p.p_p = (const float*)d_in[5]; p.p_s = (const float*)d_in[6]; p.an = (const float*)d_in[7]; p.w_in = (const float*)d_in[8]; p.qn = (const float*)d_in[9];
  p.kn = (const float*)d_in[10]; p.sinks = (const float*)d_in[11]; p.rg = (const float*)d_in[12]; p.w_out = (const float*)d_in[13]; p.fn = (const float*)d_in[14];
  p.w_gate = (const float*)d_in[15]; p.w_up = (const float*)d_in[16]; p.w_down = (const float*)d_in[17]; p.pn = (const float*)d_in[18]; p.w_ple = (const float*)d_in[19];
  p.w_pg = (const float*)d_in[20]; p.out = (float*)d_out; p.ws = (unsigned char*)d_ws;
  void* args[] = {&p};
  hipError_t e = hipLaunchCooperativeKernel((const void*)hybrid_fwd, dim3(grid_blocks), dim3(512), args, (size_t)LDS_BYTES, stream);
  if (e != hipSuccess) fprintf(stderr, "cooperative launch failed: %s (grid %d)\n", hipGetErrorString(e), grid_blocks);
}
```

```cpp
#include <hip/hip_runtime.h>
#include <hip/hip_cooperative_groups.h>
#include <cstdio>
namespace cg = cooperative_groups;
__device__ __forceinline__ int opaque_tid() { int t = (int)threadIdx.x; asm volatile("" : "+v"(t)); return t; }
namespace pg8 {
#define PG8_LAS __attribute__((address_space(3)))
typedef unsigned short bf16_t;
typedef short bf16x8 __attribute__((ext_vector_type(8)));
typedef float f32x4 __attribute__((ext_vector_type(4)));
typedef unsigned u32x4 __attribute__((ext_vector_type(4)));
constexpr int BM = 256, BK = 64, HALF = 128, HTB = HALF * BK * 2  , STAGE_BYTES = 8 * HTB, NXCD = 8, WGM = 4;

__host__ __device__ __forceinline__ int lds_byte(int r, int c) { const int st = (r >> 4) * 2 + (c >> 5), rr = r & 15, cc = c & 31, ob = rr * 64 + cc * 2; return st * 1024 + (ob ^ (((ob >> 9) & 1) << 5)); }
__host__ __device__ __forceinline__ void stage_rc(int b, int& R, int& C) { const int st = b / 1024, sb = b % 1024, swz = sb ^ (((sb >> 9) & 1) << 5); R = (st >> 1) * 16 + swz / 64; C = (st & 1) * 32 + (swz % 64) / 2; }
__host__ __device__ __forceinline__ int perm32(int rho) { const int n = rho >> 4, i = rho & 15; return 8 * (i >> 2) + 4 * n + (i & 3); }

struct Unit { int pm, pn; };
struct Gemm { const bf16_t* A; const bf16_t* Bt; int M, N, K; };

struct StaticOrder {
    int nM, nN, nwg, G, c;
    __host__ __device__ void init(int M, int N, int G_, int c_) { nM = M / BM; nN = N / BM; nwg = nM * nN; G = G_; c = c_; }
    __host__ __device__ bool next(int i, Unit& u) const {
        const long L = (long)i * G + c; if (L >= nwg) return false;
        int wgid = (int)L; { const int q = nwg / NXCD, r = nwg % NXCD, xcd = wgid % NXCD, off = wgid / NXCD; wgid = (xcd < r ? xcd * (q + 1) : r * (q + 1) + (xcd - r) * q) + off; }
        const int nig = WGM * nN, gid = wgid / nig, fm = gid * WGM, gsz = (nM - fm) < WGM ? (nM - fm) : WGM;
        u.pm = fm + ((wgid % nig) % gsz); u.pn = (wgid % nig) / gsz; return true;
    }
    __device__ __forceinline__ void a_ready(const Unit&) const {}
    __device__ __forceinline__ void done(const Unit&) const {}
};
__device__ __forceinline__ unsigned cvt_pk_bf16(float lo, float hi) { unsigned r; asm volatile("v_cvt_pk_bf16_f32 %0, %1, %2" : "=v"(r) : "v"(lo), "v"(hi)); return r; }
template <class Epi, class Sched, bool STAMP = false>
__device__ __forceinline__ void gemm_phase(PG8_LAS unsigned char* lds, const Gemm g, const Sched& S, const Epi& E, unsigned long long* stamps) {
    const int tid = opaque_tid(), wid = __builtin_amdgcn_readfirstlane(tid >> 6), lane = tid & 63, wr = wid >> 2, wc = wid & 3, fr = lane & 15, fq = lane >> 4;
    const int K = g.K, nt = K / BK;
    int ts_lo = 0, ts_hi = 0, nts = 0; const unsigned long long rt_entry = STAMP ? (unsigned long long)wall_clock64() : 0ull;
#define PG8_STAMP() do { if (STAMP && wid == 0 && nts < 64) { const unsigned long long _c = (unsigned long long)clock64(); \
        ts_lo = (lane == nts) ? (int)(unsigned)_c : ts_lo; ts_hi = (lane == nts) ? (int)(unsigned)(_c >> 32) : ts_hi; ++nts; } } while (0)
    PG8_STAMP();
    unsigned voffA[2], voffB[2];
#pragma unroll
    for (int i = 0; i < 2; ++i) { int R, C; stage_rc(tid * 16 + i * 8192, R, C); const int Rb = Epi::PERM ? ((R & ~31) + perm32(R & 31)) : R;
        voffA[i] = (unsigned)(R * K + C) * 2u; voffB[i] = (unsigned)(Rb * K + C) * 2u; }
    const size_t kstep = (size_t)(BK * 2);
    const size_t hstep = (size_t)HALF * K * 2;
    const size_t tstep = 2 * hstep;
    const unsigned ldsw = (unsigned)wid * 1024u;
    const int aoff = lds_byte(wr * 64 + fr, fq * 8), boff = lds_byte(wc * 32 + fr, fq * 8);
#define PG8_SA(b, h) (((b) * 2 + (h)) * HTB)
#define PG8_SB(b, h) ((4 + (b) * 2 + (h)) * HTB)
#define PG8_STAGE(bufoff, gbase, voff) do { _Pragma("unroll") for (int _i = 0; _i < 2; ++_i) \
        __builtin_amdgcn_global_load_lds((const unsigned*)((const char*)(gbase) + (voff)[_i]), (PG8_LAS unsigned*)(lds + (bufoff) + ldsw + _i * 8192), 16, 0, 0); } while (0)
#define PG8_LDA(dst, b, h) do { _Pragma("unroll") for (int m = 0; m < 4; ++m) _Pragma("unroll") for (int k = 0; k < 2; ++k) dst[m][k] = *(const PG8_LAS bf16x8*)(lds + PG8_SA(b, h) + aoff + m * 2048 + k * 1024); } while (0)
#define PG8_LDB(dst, b, h) do { _Pragma("unroll") for (int n = 0; n < 2; ++n) _Pragma("unroll") for (int k = 0; k < 2; ++k) dst[n][k] = *(const PG8_LAS bf16x8*)(lds + PG8_SB(b, h) + boff + n * 2048 + k * 1024); } while (0)
#define PG8_MMA(ai, bj, At, Bt) do { __builtin_amdgcn_s_setprio(1); _Pragma("unroll") for (int m = 0; m < 4; ++m) _Pragma("unroll") for (int n = 0; n < 2; ++n) _Pragma("unroll") for (int k = 0; k < 2; ++k) \
        acc[ai][bj][m][n] = __builtin_amdgcn_mfma_f32_16x16x32_bf16(Bt[n][k], At[m][k], acc[ai][bj][m][n], 0, 0, 0); __builtin_amdgcn_s_setprio(0); } while (0)
#define PG8_WAIT_V(n) asm volatile("s_waitcnt vmcnt(" #n ")" ::: "memory")
#define PG8_WAIT_L(n) asm volatile("s_waitcnt lgkmcnt(" #n ")" ::: "memory")
#define PG8_BAR __builtin_amdgcn_s_barrier()
#define PG8_SCHED __builtin_amdgcn_sched_barrier(0)
    Unit cur, nxt; int ui = 0;
    if (!S.next(0, cur)) return;
    f32x4 acc[2][2][4][2];
#pragma unroll
    for (int a = 0; a < 2; ++a)
#pragma unroll
        for (int b = 0; b < 2; ++b)
#pragma unroll
            for (int m = 0; m < 4; ++m)
#pragma unroll
                for (int n = 0; n < 2; ++n) acc[a][b][m][n] = (f32x4){0.f, 0.f, 0.f, 0.f};
    bf16x8 At[4][2], B0[2][2], B1[2][2];
    const char* cA = (const char*)g.A + (size_t)cur.pm * tstep; const char* cB = (const char*)g.Bt + (size_t)cur.pn * tstep;
    S.a_ready(cur);
    PG8_STAGE(PG8_SB(0, 0), cB, voffB); PG8_STAGE(PG8_SA(0, 0), cA, voffA); PG8_STAGE(PG8_SB(0, 1), cB + hstep, voffB); PG8_STAGE(PG8_SA(0, 1), cA + hstep, voffA);
    if (wr == 1) PG8_BAR;
    PG8_WAIT_V(4); PG8_BAR;
    PG8_STAGE(PG8_SB(1, 0), cB + kstep, voffB); PG8_STAGE(PG8_SA(1, 0), cA + kstep, voffA); PG8_STAGE(PG8_SB(1, 1), cB + hstep + kstep, voffB);
    PG8_WAIT_V(6); PG8_BAR;
    PG8_STAMP();
    for (;;) {
        const bool has_next = S.next(ui + 1, nxt);
        const char* nA = has_next ? (const char*)g.A + (size_t)nxt.pm * tstep : cA; const char* nB = has_next ? (const char*)g.Bt + (size_t)nxt.pn * tstep : cB;
        for (int t = 0; t < nt; t += 2) {
            const bool last = (t == nt - 2);
            const char* a1 = cA + (size_t)(t + 1) * kstep;
            const char* a2 = last ? nA : cA + (size_t)(t + 2) * kstep; const char* b2 = last ? nB : cB + (size_t)(t + 2) * kstep;
            const char* a3 = a2 + kstep; const char* b3 = b2 + kstep;
            if (last && has_next) S.a_ready(nxt);
            PG8_LDB(B0, 0, 0); PG8_SCHED; PG8_LDA(At, 0, 0); PG8_STAGE(PG8_SA(1, 1), a1 + hstep, voffA);
            PG8_WAIT_L(8); PG8_BAR; PG8_WAIT_L(0); PG8_MMA(0, 0, At, B0); PG8_BAR; PG8_SCHED;
            PG8_LDB(B1, 0, 1); PG8_STAGE(PG8_SB(0, 0), b2, voffB);
            PG8_BAR; PG8_WAIT_L(0); PG8_MMA(0, 1, At, B1); PG8_BAR;
            PG8_LDA(At, 0, 1); PG8_STAGE(PG8_SA(0, 0), a2, voffA);
            PG8_BAR; PG8_WAIT_L(0); PG8_MMA(1, 0, At, B0); PG8_BAR; PG8_SCHED;
            PG8_STAGE(PG8_SB(0, 1), b2 + hstep, voffB);
            PG8_WAIT_V(6); PG8_BAR; PG8_MMA(1, 1, At, B1); PG8_BAR;
            PG8_LDB(B0, 1, 0); PG8_SCHED; PG8_LDA(At, 1, 0); PG8_STAGE(PG8_SA(0, 1), a2 + hstep, voffA);
            PG8_WAIT_L(8); PG8_BAR; PG8_WAIT_L(0); PG8_MMA(0, 0, At, B0); PG8_BAR; PG8_SCHED;
            PG8_LDB(B1, 1, 1); PG8_STAGE(PG8_SB(1, 0), b3, voffB);
            PG8_BAR; PG8_WAIT_L(0); PG8_MMA(0, 1, At, B1); PG8_BAR;
            PG8_LDA(At, 1, 1); PG8_STAGE(PG8_SA(1, 0), a3, voffA);
            PG8_BAR; PG8_WAIT_L(0); PG8_MMA(1, 0, At, B0); PG8_BAR; PG8_SCHED;
            PG8_STAGE(PG8_SB(1, 1), b3 + hstep, voffB);
            PG8_WAIT_V(6); PG8_BAR; PG8_MMA(1, 1, At, B1); PG8_BAR;
        }
        PG8_STAMP();
        if constexpr (!Epi::AFTER_DRAIN) { E(acc, cur, wr, wc, fr, fq); S.done(cur); }
        PG8_STAMP();
        if (!has_next) break;
#pragma unroll
        for (int a = 0; a < 2; ++a)
#pragma unroll
            for (int b = 0; b < 2; ++b)
#pragma unroll
                for (int m = 0; m < 4; ++m)
#pragma unroll
                    for (int n = 0; n < 2; ++n) acc[a][b][m][n] = (f32x4){0.f, 0.f, 0.f, 0.f};
        cur = nxt; cA = nA; cB = nB; ++ui;
    }
    PG8_WAIT_V(0);
    if (wr == 0) PG8_BAR;
    PG8_BAR;
    if constexpr (Epi::AFTER_DRAIN) { E.fused(acc, cur, wr, wc, fr, fq, lds, wid, lane); S.done(cur); }
    PG8_STAMP();
    if (STAMP && wid == 0) { stamps[lane] = lane < nts ? (((unsigned long long)(unsigned)ts_hi << 32) | (unsigned)ts_lo) : 0ull;
        if (lane == 62) stamps[62] = rt_entry; if (lane == 63) stamps[63] = (unsigned long long)wall_clock64(); }
#undef PG8_STAMP
#undef PG8_SA
#undef PG8_SB
#undef PG8_STAGE
#undef PG8_LDA
#undef PG8_LDB
#undef PG8_MMA
#undef PG8_WAIT_V
#undef PG8_WAIT_L
#undef PG8_BAR
#undef PG8_SCHED
}
}

#define LAS __attribute__((address_space(3)))
#define XB_TMO      128
#define XB_XCNT(j)  (256  + 64 * (j))
#define XB_XSUB(j)  (1280 + 64 * (j))
#define XB_XGEN(j)  (2304 + 64 * (j))
#define XB_TOP      3328
#define XB_TOPGEN   3392
#define XCD_BAR_WORDS 3456
#define XB_SPIN_CAP (1u << 18)

__device__ __forceinline__ unsigned xb_ld(unsigned* p)              { return __hip_atomic_load(p, __ATOMIC_RELAXED, __HIP_MEMORY_SCOPE_AGENT); }
__device__ __forceinline__ unsigned xb_add(unsigned* p, unsigned v) { return __hip_atomic_fetch_add(p, v, __ATOMIC_RELAXED, __HIP_MEMORY_SCOPE_AGENT); }
__device__ __forceinline__ unsigned xb_xcc_id() { return (unsigned)__builtin_amdgcn_s_getreg((3 << 11) | 20) & 0xFu; }
#define XB_SPIN(cond, bar) do { unsigned _sp = 0; while (cond) { __builtin_amdgcn_s_sleep(1); \
    if ((++_sp & 255u) == 0u) { if (xb_ld(&(bar)[XB_TMO])) break; if (_sp > XB_SPIN_CAP) { atomicAdd(&(bar)[XB_TMO], 1u); break; } } } } while (0)

struct XcdBarrier {
    unsigned* bar; unsigned x;
    volatile LAS unsigned* st;
};

__device__ __forceinline__ XcdBarrier xcd_barrier_post(unsigned* bar, volatile LAS unsigned* st) {
    XcdBarrier b; b.bar = bar; b.x = xb_xcc_id(); b.st = st;
    if (threadIdx.x == 0) (void)xb_add(&bar[XB_XCNT(b.x)], 1u);
    return b;
}
__device__ __forceinline__ void xcd_barrier_complete(unsigned* bar, unsigned x, unsigned& nloc, unsigned& nx) {
    const unsigned G = gridDim.x * gridDim.y * gridDim.z;
    unsigned sum, cnt, mine, sp = 0u;
    for (;;) {
        sum = 0u; cnt = 0u; mine = 0u;
#pragma unroll
        for (unsigned j = 0; j < 16; ++j) { const unsigned c = xb_ld(&bar[XB_XCNT(j)]); sum += c; cnt += (c > 0u) ? 1u : 0u; mine = (j == x) ? c : mine; }
        if (sum == G) break;
        __builtin_amdgcn_s_sleep(1);
        if ((++sp & 255u) == 0u) { if (xb_ld(&bar[XB_TMO])) break; if (sp > XB_SPIN_CAP) { atomicAdd(&bar[XB_TMO], 1u); break; } }
    }
    nloc = mine > 0u ? mine : 1u; nx = cnt > 0u ? cnt : 1u;
}

__device__ __forceinline__ void xcd_barrier(const XcdBarrier& b) {
    asm volatile("s_waitcnt vmcnt(0)" ::: "memory");
    __syncthreads();
    if (threadIdx.x == 0) {
        unsigned* bar = b.bar;
        __builtin_amdgcn_s_waitcnt(0);
        unsigned nloc = b.st[0], nx = b.st[1];
        if (nloc == 0u) { xcd_barrier_complete(bar, b.x, nloc, nx); b.st[0] = nloc; b.st[1] = nx; }
        const unsigned old = xb_add(&bar[XB_XSUB(b.x)], 1u);
        const unsigned gen = old / nloc;
        if (old + 1u == (gen + 1u) * nloc) {
            __builtin_amdgcn_fence(__ATOMIC_RELEASE, "agent");
            asm volatile("s_waitcnt vmcnt(0)" ::: "memory");
            const unsigned og = xb_add(&bar[XB_TOP], 1u);
            const unsigned tg = og / nx;
            if (og + 1u == (tg + 1u) * nx) xb_add(&bar[XB_TOPGEN], 1u);
            else XB_SPIN(xb_ld(&bar[XB_TOPGEN]) == tg, bar);
            __builtin_amdgcn_fence(__ATOMIC_ACQUIRE, "agent");
            xb_add(&bar[XB_XGEN(b.x)], 1u);
            asm volatile("s_waitcnt vmcnt(0)" ::: "memory");
        } else {
            XB_SPIN(xb_ld(&bar[XB_XGEN(b.x)]) == gen, bar);
            __builtin_amdgcn_fence(__ATOMIC_ACQUIRE, "agent");
            asm volatile("s_waitcnt vmcnt(0)" ::: "memory");
        }
    }
    __syncthreads();
}
using namespace pg8;

typedef unsigned u32x2 __attribute__((ext_vector_type(2)));
typedef float f32x2v __attribute__((ext_vector_type(2)));

constexpr int DM = 2048, SEQ = 4096, NTOK_P = 8192, NTOK = 8224, M_PAD = 8448, NIN = 5632, DFF = 5632, PLE = 256;
constexpr int ZC_AQ = 0, ZC_AK = 1024, ZC_AV = 1280, ZC_RQ = 1536, ZC_RK = 2560, ZC_RV = 3584, ZC_RG = 4608;
constexpr float EPS = 1e-6f;
constexpr float ATTN_SCALE = 0.08838834764831845f, RET_K_SCALE = 0.08838834764831845f;
constexpr size_t O_YP = 0, O_YS = 16777216, O_KWP = 16842752, O_VWP = 16908288, O_RSP = 16973824, O_KWS = 17235968, O_VWS = 18284544, O_RSS = 19333120;
constexpr size_t W_IN = 0;
constexpr size_t W_OUT = W_IN + (size_t)NIN * DM * 2;
constexpr size_t W_GU = W_OUT + (size_t)DM * DM * 2;
constexpr size_t W_DOWN = W_GU + (size_t)2 * DFF * DM * 2;
constexpr size_t W_PLE = W_DOWN + (size_t)DM * DFF * 2;
constexpr size_t W_PG = W_PLE + (size_t)DM * PLE * 2;
constexpr size_t BUF_A = W_PG + (size_t)DM * DM * 2;
constexpr size_t BUF_B = BUF_A + (size_t)M_PAD * DM * 2;
constexpr size_t BUF_Z = BUF_B + (size_t)M_PAD * DM * 2;
constexpr size_t BUF_P = BUF_Z + (size_t)M_PAD * NIN * 2;
constexpr size_t BUF_RS = BUF_P + (size_t)M_PAD * PLE * 2;
constexpr size_t BUF_ROPE = BUF_RS + (size_t)2 * M_PAD * 4;
constexpr size_t BUF_BAR = ((BUF_ROPE + (size_t)2 * 4097 * 64 * 4 + 255) / 256) * 256;
constexpr size_t BUF_MIX = ((BUF_BAR + (size_t)XCD_BAR_WORDS * 4 + 255) / 256) * 256;
constexpr size_t BUF_XS = BUF_MIX + (size_t)M_PAD * DM * 2;
constexpr size_t WS_END = BUF_XS + (size_t)M_PAD * 4;
constexpr size_t BUF_KV16 = BUF_B;
constexpr size_t BUF_S16 = BUF_B + (size_t)512 * 16384 * 2;
constexpr int LDS_PHASE_BYTES = 141312, LDS_BYTES = LDS_PHASE_BYTES + 16;

struct Params {
  const float *x_p, *x_s, *ck, *cv, *st, *p_p, *p_s, *an, *w_in, *qn, *kn, *sinks, *rg, *w_out, *fn, *w_gate, *w_up, *w_down, *pn, *w_ple, *w_pg;
  float* out; unsigned char* ws; int never; int pad0;
};

__device__ __forceinline__ float bf_lo(unsigned w) { return __uint_as_float(w << 16); }
__device__ __forceinline__ float bf_hi(unsigned w) { return __uint_as_float(w & 0xffff0000u); }
__device__ __forceinline__ float bf2f(bf16_t v) { return __uint_as_float(((unsigned)v) << 16); }
__device__ __forceinline__ void unpack8(const u32x4 w, float (&f)[8]) {
  f[0] = bf_lo(w.x); f[1] = bf_hi(w.x); f[2] = bf_lo(w.y); f[3] = bf_hi(w.y); f[4] = bf_lo(w.z); f[5] = bf_hi(w.z); f[6] = bf_lo(w.w); f[7] = bf_hi(w.w);
}
__device__ __forceinline__ u32x4 pack8(const float (&f)[8]) {
  u32x4 w; w.x = cvt_pk_bf16(f[0], f[1]); w.y = cvt_pk_bf16(f[2], f[3]); w.z = cvt_pk_bf16(f[4], f[5]); w.w = cvt_pk_bf16(f[6], f[7]); return w;
}
__device__ __forceinline__ unsigned half_of(const u32x4 w, int e) { const unsigned x = (e >> 1) == 0 ? w.x : (e >> 1) == 1 ? w.y : (e >> 1) == 2 ? w.z : w.w; return (e & 1) ? (x >> 16) : (x & 0xffffu); }
__device__ __forceinline__ float sigmoid_f(float x) { return __builtin_amdgcn_rcpf(1.0f + __builtin_amdgcn_exp2f(x * -1.4426950408889634f)); }
__device__ __forceinline__ float silu_f(float x) { return x * sigmoid_f(x); }
__device__ __forceinline__ float wave_sum(float v) { for (int o = 32; o >= 1; o >>= 1) v += __shfl_xor(v, o); return v; }
__device__ __forceinline__ float wave_max(float v) { for (int o = 32; o >= 1; o >>= 1) v = fmaxf(v, __shfl_xor(v, o)); return v; }
__device__ __forceinline__ float ret_lg(int h) { return log1pf(-exp2f(-5.0f - (float)h)); }

struct EpiZ {
  static constexpr bool PERM = true, AFTER_DRAIN = false;
  bf16_t* O; int ldc;
  __device__ __forceinline__ void operator()(const f32x4 (&acc)[2][2][4][2], const Unit& u, int wr, int wc, int fr, int fq) const {
    const int row0 = u.pm * BM + wr * 64 + fr, col0 = u.pn * BM + wc * 32 + 8 * fq;
#pragma unroll
    for (int ai = 0; ai < 2; ++ai)
#pragma unroll
      for (int m = 0; m < 4; ++m) { bf16_t* rowp = O + (size_t)(row0 + ai * HALF + m * 16) * ldc + col0;
#pragma unroll
        for (int bj = 0; bj < 2; ++bj) { const f32x4 v0 = acc[ai][bj][m][0], v1 = acc[ai][bj][m][1];
          u32x4 w; w.x = cvt_pk_bf16(v0[0], v0[1]); w.y = cvt_pk_bf16(v0[2], v0[3]); w.z = cvt_pk_bf16(v1[0], v1[1]); w.w = cvt_pk_bf16(v1[2], v1[3]);
          *(u32x4*)(rowp + bj * HALF) = w; } }
  }
};
struct EpiRes3 {
  static constexpr bool PERM = true, AFTER_DRAIN = false;
  const bf16_t* A0; const float* xs; const float* an; bf16_t* HG; const float* g; float* rs;
  __device__ __forceinline__ void operator()(const f32x4 (&acc)[2][2][4][2], const Unit& u, int wr, int wc, int fr, int fq) const {
    const int row0 = u.pm * BM + wr * 64 + fr, col0 = u.pn * BM + wc * 32 + 8 * fq;
    float gi[2][8];
#pragma unroll
    for (int bj = 0; bj < 2; ++bj)
#pragma unroll
      for (int hf = 0; hf < 2; ++hf) { const f32x4 a = *(const f32x4*)(an + col0 + bj * HALF + hf * 4);
#pragma unroll
        for (int j = 0; j < 4; ++j) gi[bj][hf * 4 + j] = __builtin_amdgcn_rcpf(a[j]); }
#pragma unroll
    for (int ai = 0; ai < 2; ++ai) {
#pragma unroll
     for (int mb = 0; mb < 4; mb += 2) {
      u32x4 rr[4][2]; float xr[4];
#pragma unroll
      for (int m = mb; m < mb + 2; ++m) { xr[m] = xs[row0 + ai * HALF + m * 16];
#pragma unroll
        for (int bj = 0; bj < 2; ++bj) rr[m][bj] = *(const u32x4*)(A0 + (size_t)(row0 + ai * HALF + m * 16) * DM + col0 + bj * HALF); }
#pragma unroll
      for (int m = mb; m < mb + 2; ++m) {
        const int row = row0 + ai * HALF + m * 16; bf16_t* hp = HG + (size_t)row * DM + col0; float ss = 0.f;
#pragma unroll
        for (int bj = 0; bj < 2; ++bj) {
          float h[8]; unpack8(rr[m][bj], h);
#pragma unroll
          for (int j = 0; j < 8; ++j) { h[j] = h[j] * xr[m] * gi[bj][j] + acc[ai][bj][m][j >> 2][j & 3]; ss += h[j] * h[j]; }
          { const f32x4 o0 = *(const f32x4*)(g + col0 + bj * HALF), o1 = *(const f32x4*)(g + col0 + bj * HALF + 4);
#pragma unroll
            for (int j = 0; j < 8; ++j) h[j] *= (j < 4 ? o0[j & 3] : o1[j & 3]); }
          *(u32x4*)(hp + bj * HALF) = pack8(h); }
        ss += __shfl_xor(ss, 16); ss += __shfl_xor(ss, 32);
        if (fq == 0) atomicAdd(rs + row, ss);
      }
     }
    }
  }
};
struct EpiRes5 {
  static constexpr bool PERM = true, AFTER_DRAIN = false;
  const bf16_t* HGin; const float* gin; bf16_t* HGout; const float* gout; float* rs;
  __device__ __forceinline__ void operator()(const f32x4 (&acc)[2][2][4][2], const Unit& u, int wr, int wc, int fr, int fq) const {
    const int row0 = u.pm * BM + wr * 64 + fr, col0 = u.pn * BM + wc * 32 + 8 * fq;
    float gi[2][8];
#pragma unroll
    for (int bj = 0; bj < 2; ++bj)
#pragma unroll
      for (int hf = 0; hf < 2; ++hf) { const f32x4 a = *(const f32x4*)(gin + col0 + bj * HALF + hf * 4);
#pragma unroll
        for (int j = 0; j < 4; ++j) gi[bj][hf * 4 + j] = __builtin_amdgcn_rcpf(a[j]); }
#pragma unroll
    for (int ai = 0; ai < 2; ++ai) {
#pragma unroll
     for (int mb = 0; mb < 4; mb += 2) {
      u32x4 rr[4][2];
#pragma unroll
      for (int m = mb; m < mb + 2; ++m)
#pragma unroll
        for (int bj = 0; bj < 2; ++bj) rr[m][bj] = *(const u32x4*)(HGin + (size_t)(row0 + ai * HALF + m * 16) * DM + col0 + bj * HALF);
#pragma unroll
      for (int m = mb; m < mb + 2; ++m) {
        const int row = row0 + ai * HALF + m * 16; bf16_t* hp = HGout + (size_t)row * DM + col0; float ss = 0.f;
#pragma unroll
        for (int bj = 0; bj < 2; ++bj) {
          float h[8]; unpack8(rr[m][bj], h);
#pragma unroll
          for (int j = 0; j < 8; ++j) { h[j] = h[j] * gi[bj][j] + acc[ai][bj][m][j >> 2][j & 3]; ss += h[j] * h[j]; }
          { const f32x4 o0 = *(const f32x4*)(gout + col0 + bj * HALF), o1 = *(const f32x4*)(gout + col0 + bj * HALF + 4);
#pragma unroll
            for (int j = 0; j < 8; ++j) h[j] *= (j < 4 ? o0[j & 3] : o1[j & 3]); }
          *(u32x4*)(hp + bj * HALF) = pack8(h); }
        ss += __shfl_xor(ss, 16); ss += __shfl_xor(ss, 32);
        if (fq == 0) atomicAdd(rs + row, ss);
      }
     }
    }
  }
};
struct EpiAct {
  static constexpr bool PERM = true, AFTER_DRAIN = false;
  bf16_t* O; const float* rs;
  __device__ __forceinline__ void operator()(const f32x4 (&acc)[2][2][4][2], const Unit& u, int wr, int wc, int fr, int fq) const {
    const int row0 = u.pm * BM + wr * 64 + fr, col0 = u.pn * HALF + wc * 32 + 8 * fq;
#pragma unroll
    for (int ai = 0; ai < 2; ++ai)
#pragma unroll
      for (int m = 0; m < 4; ++m) {
        const int row = row0 + ai * HALF + m * 16;
        const float r = rsqrtf(rs[row] * (1.0f / DM) + EPS);
        float a[8];
#pragma unroll
        for (int n = 0; n < 2; ++n)
#pragma unroll
          for (int j = 0; j < 4; ++j) { const float gg = acc[ai][0][m][n][j] * r, uu = acc[ai][1][m][n][j] * r; a[n * 4 + j] = silu_f(gg) * uu; }
        *(u32x4*)(O + (size_t)row * DFF + col0) = pack8(a);
      }
  }
};
struct EpiPle {
  static constexpr bool PERM = true, AFTER_DRAIN = false;
  float* out; const bf16_t* HG; const float* g; const bf16_t* T; const float* rs;
  __device__ __forceinline__ void operator()(const f32x4 (&acc)[2][2][4][2], const Unit& u, int wr, int wc, int fr, int fq) const {
    const int row0 = u.pm * BM + wr * 64 + fr, col0 = u.pn * BM + wc * 32 + 8 * fq;
    float gi[2][8];
#pragma unroll
    for (int bj = 0; bj < 2; ++bj)
#pragma unroll
      for (int hf = 0; hf < 2; ++hf) { const f32x4 a = *(const f32x4*)(g + col0 + bj * HALF + hf * 4);
#pragma unroll
        for (int j = 0; j < 4; ++j) gi[bj][hf * 4 + j] = __builtin_amdgcn_rcpf(a[j]); }
#pragma unroll
    for (int ai = 0; ai < 2; ++ai) {
#pragma unroll
     for (int mb = 0; mb < 4; mb += 2) {
      u32x4 rh[4][2], rt[4][2]; float rr[4];
#pragma unroll
      for (int m = mb; m < mb + 2; ++m) { const int row = row0 + ai * HALF + m * 16; rr[m] = rs[row];
#pragma unroll
        for (int bj = 0; bj < 2; ++bj) { rh[m][bj] = *(const u32x4*)(HG + (size_t)row * DM + col0 + bj * HALF); rt[m][bj] = *(const u32x4*)(T + (size_t)row * DM + col0 + bj * HALF); } }
#pragma unroll
      for (int m = mb; m < mb + 2; ++m) {
        const int row = row0 + ai * HALF + m * 16; const float r = rsqrtf(rr[m] * (1.0f / DM) + EPS); float* op = out + (size_t)row * DM + col0;
#pragma unroll
        for (int bj = 0; bj < 2; ++bj) {
          float h[8], t[8]; unpack8(rh[m][bj], h); unpack8(rt[m][bj], t);
#pragma unroll
          for (int j = 0; j < 8; ++j) h[j] = h[j] * gi[bj][j] + t[j] * sigmoid_f(acc[ai][bj][m][j >> 2][j & 3] * r);
          *(f32x4*)(op + bj * HALF) = (f32x4){h[0], h[1], h[2], h[3]}; *(f32x4*)(op + bj * HALF + 4) = (f32x4){h[4], h[5], h[6], h[7]}; }
      }
     }
    }
  }
};
struct TDesc { const float* src; bf16_t* dst; int K, N, rs, off, t; };
constexpr int TT_IN = (DM / 128) * (NIN / 64), TT_OUT = (DM / 128) * (DM / 64), TT_G = (DM / 128) * (DFF / 64), TT_D = (DFF / 128) * (DM / 64), TT_PL = (PLE / 128) * (DM / 64), TT_PG = TT_OUT;
template <int LIST> __device__ __forceinline__ int tjobs() { return LIST == 0 ? TT_IN + 2 * TT_G + TT_OUT + TT_PG + TT_PL : LIST == 1 ? 0 : TT_D; }
template <int LIST> __device__ __forceinline__ TDesc tdesc(const Params& p, int g) {
  unsigned char* ws = p.ws; TDesc d;
  if (LIST == 0) {
    if (g < TT_IN) d = TDesc{p.w_in, (bf16_t*)(ws + W_IN), DM, NIN, 128, 0, g};
    else if (g < TT_IN + TT_G) d = TDesc{p.w_gate, (bf16_t*)(ws + W_GU), DM, DFF, 256, 0, g - TT_IN};
    else if (g < TT_IN + 2 * TT_G) d = TDesc{p.w_up, (bf16_t*)(ws + W_GU), DM, DFF, 256, 128, g - TT_IN - TT_G};
    else if (g < TT_IN + 2 * TT_G + TT_OUT) d = TDesc{p.w_out, (bf16_t*)(ws + W_OUT), DM, DM, 128, 0, g - TT_IN - 2 * TT_G};
    else if (g < TT_IN + 2 * TT_G + TT_OUT + TT_PG) d = TDesc{p.w_pg, (bf16_t*)(ws + W_PG), DM, DM, 128, 0, g - TT_IN - 2 * TT_G - TT_OUT};
    else d = TDesc{p.w_ple, (bf16_t*)(ws + W_PLE), PLE, DM, 128, 0, g - TT_IN - 2 * TT_G - TT_OUT - TT_PG};
  } else if (LIST == 1) d = TDesc{p.w_out, (bf16_t*)(ws + W_OUT), DM, DM, 128, 0, g};
  else {
    d = TDesc{p.w_down, (bf16_t*)(ws + W_DOWN), DFF, DM, 128, 0, g};
  }
  return d;
}
template <int LIST> __device__ __forceinline__ void tload4(const Params& p, int g0, int step, f32x4 (&v)[4][4]) {
  const int tid = opaque_tid(), njobs = tjobs<LIST>();
#pragma unroll
  for (int u = 0; u < 4; ++u) { const int g = g0 + u * step;
    if (g < njobs) { const TDesc d = tdesc<LIST>(p, g); const int nnt = d.N >> 7, k0 = (d.t / nnt) * 64, n0 = (d.t % nnt) * 128;
#pragma unroll
      for (int i = 0; i < 4; ++i) v[u][i] = __builtin_nontemporal_load((const f32x4*)(d.src + (size_t)(k0 + (tid >> 5) + 16 * i) * d.N + n0 + (tid & 31) * 4)); } }
}
template <int LIST> __device__ __forceinline__ void transpose_jobs(const Params& p, LAS unsigned char* lds, int first, int step) {
  const int tid = opaque_tid(), njobs = tjobs<LIST>();
  if (first >= njobs) return;
  f32x4 v[4][4], vn[4][4];
  tload4<LIST>(p, first, step, v);
  for (int g0 = first; g0 < njobs; g0 += 4 * step) {
    const bool more = g0 + 4 * step < njobs;
    if (more) tload4<LIST>(p, g0 + 4 * step, step, vn);
#pragma unroll
    for (int u = 0; u < 4; ++u) { if (g0 + u * step < njobs) { LAS float* tile = (LAS float*)lds + u * (64 * 129);
#pragma unroll
        for (int i = 0; i < 4; ++i) { LAS float* q = tile + ((tid >> 5) + 16 * i) * 129 + (tid & 31) * 4; q[0] = v[u][i][0]; q[1] = v[u][i][1]; q[2] = v[u][i][2]; q[3] = v[u][i][3]; } } }
    __syncthreads();
#pragma unroll
    for (int u = 0; u < 4; ++u) { const int g = g0 + u * step;
      if (g < njobs) { const TDesc d = tdesc<LIST>(p, g); const int nnt = d.N >> 7, k0 = (d.t / nnt) * 64, n0 = (d.t % nnt) * 128;
        const LAS float* tile = (const LAS float*)lds + u * (64 * 129);
        const int n = tid >> 2, kb = (tid & 3) * 16; float f[16];
#pragma unroll
        for (int j = 0; j < 16; ++j) f[j] = tile[(kb + j) * 129 + n];
        const int nn = n0 + n, drow = (nn >> 7) * d.rs + (nn & 127) + d.off;
        bf16_t* dp = d.dst + (size_t)drow * d.K + k0 + kb;
        u32x4 w0, w1;
        w0.x = cvt_pk_bf16(f[0], f[1]); w0.y = cvt_pk_bf16(f[2], f[3]); w0.z = cvt_pk_bf16(f[4], f[5]); w0.w = cvt_pk_bf16(f[6], f[7]);
        w1.x = cvt_pk_bf16(f[8], f[9]); w1.y = cvt_pk_bf16(f[10], f[11]); w1.z = cvt_pk_bf16(f[12], f[13]); w1.w = cvt_pk_bf16(f[14], f[15]);
        *(u32x4*)dp = w0; *(u32x4*)(dp + 8) = w1; } }
    __syncthreads();
    if (more) {
#pragma unroll
      for (int u = 0; u < 4; ++u)
#pragma unroll
        for (int i = 0; i < 4; ++i) v[u][i] = vn[u][i]; }
  }
}

__device__ __forceinline__ void phase_prep(const Params& p, LAS unsigned char* lds) {
  const int tid = opaque_tid(), wid = __builtin_amdgcn_readfirstlane(tid >> 6), lane = tid & 63;
  unsigned char* ws = p.ws;
  transpose_jobs<0>(p, lds, blockIdx.x, gridDim.x);
  {
    bf16_t* A0 = (bf16_t*)(ws + BUF_A);
    for (int row = blockIdx.x * 8 + wid; row < M_PAD; row += gridDim.x * 8) {
      bf16_t* dst = A0 + (size_t)row * DM;
      if (row >= NTOK) {
#pragma unroll
        for (int i = 0; i < 8; ++i) *(u32x2*)(dst + (i * 64 + lane) * 4) = (u32x2){0u, 0u};
        continue;
      }
      const float* src = row < NTOK_P ? p.x_p + (size_t)row * DM : p.x_s + (size_t)(row - NTOK_P) * DM;
      f32x4 v[8]; float ss = 0.f;
#pragma unroll
      for (int i = 0; i < 8; ++i) { v[i] = __builtin_nontemporal_load((const f32x4*)(src + (i * 64 + lane) * 4)); ss += v[i][0] * v[i][0] + v[i][1] * v[i][1] + v[i][2] * v[i][2] + v[i][3] * v[i][3]; }
      ss = wave_sum(ss);
      const float r = rsqrtf(ss * (1.0f / DM) + EPS);
      if (lane == 0) ((float*)(ws + BUF_XS))[row] = sqrtf(ss * (1.0f / DM) + EPS);
#pragma unroll
      for (int i = 0; i < 8; ++i) { const f32x4 g = *(const f32x4*)(p.an + (i * 64 + lane) * 4); const f32x4 y = v[i] * r * g;
        *(u32x2*)(dst + (i * 64 + lane) * 4) = (u32x2){cvt_pk_bf16(y[0], y[1]), cvt_pk_bf16(y[2], y[3])}; }
    }
  }
  const size_t gtid = (size_t)blockIdx.x * 512 + tid, gstride = (size_t)gridDim.x * 512;
  {
    bf16_t* P = (bf16_t*)(ws + BUF_P);
    for (size_t i = gtid; i < (size_t)M_PAD * 64; i += gstride) {
      const int row = (int)(i >> 6), c4 = (int)(i & 63) * 4;
      f32x4 v = (f32x4){0.f, 0.f, 0.f, 0.f};
      if (row < NTOK_P) v = *(const f32x4*)(p.p_p + (size_t)row * PLE + c4); else if (row < NTOK) v = *(const f32x4*)(p.p_s + (size_t)(row - NTOK_P) * PLE + c4);
      *(u32x2*)(P + (size_t)row * PLE + c4) = (u32x2){cvt_pk_bf16(v[0], v[1]), cvt_pk_bf16(v[2], v[3])};
    }
  }
  { float* rs = (float*)(ws + BUF_RS); for (size_t i = gtid; i < (size_t)2 * M_PAD; i += gstride) rs[i] = 0.f; }
  {
    float* rc = (float*)(ws + BUF_ROPE); float* rsn = rc + 4097 * 64;
    for (size_t i = gtid; i < (size_t)4097 * 64; i += gstride) {
      const int e = (int)(i >> 6), j = (int)(i & 63);
      const float pos = e < 4096 ? (float)e : 16384.0f;
      const float inv = (float)exp2(-(double)j * (13.287712379549449 / 64.0));
      const float ang = pos * inv;
      const double rev = (double)ang * 0.15915494309189535; const float fr = (float)(rev - floor(rev));
      rc[i] = __builtin_amdgcn_cosf(fr); rsn[i] = __builtin_amdgcn_sinf(fr);
    }
  }
}

#define MFMA16(a, b, c) __builtin_amdgcn_mfma_f32_16x16x32_bf16((a), (b), (c), 0, 0, 0)
constexpr int LDR = 272;
__device__ __forceinline__ void wave_store_rows16(const LAS unsigned char* buf, int rs, bf16_t* g, size_t grs, int lane) {
#pragma unroll
  for (int i = 0; i < 4; ++i) { const int row = (lane >> 4) + 4 * i, ch = lane & 15; *(u32x4*)(g + (size_t)row * grs + ch * 8) = *(const LAS u32x4*)(buf + row * rs + ch * 16); }
}

__device__ __forceinline__ void rot16(const bf16_t* zrow, int cc, const float* rc, const float* rsn, int pos_entry, float sc, float (&o1)[8], float (&o2)[8]) {
  float x1[8], x2[8]; unpack8(*(const u32x4*)(zrow + cc * 8), x1); unpack8(*(const u32x4*)(zrow + 64 + cc * 8), x2);
  const f32x4 c0 = *(const f32x4*)(rc + pos_entry * 64 + cc * 8), c1 = *(const f32x4*)(rc + pos_entry * 64 + cc * 8 + 4);
  const f32x4 s0 = *(const f32x4*)(rsn + pos_entry * 64 + cc * 8), s1 = *(const f32x4*)(rsn + pos_entry * 64 + cc * 8 + 4);
#pragma unroll
  for (int e = 0; e < 8; ++e) { const float cs = e < 4 ? c0[e & 3] : c1[e & 3], sn = e < 4 ? s0[e & 3] : s1[e & 3];
    o1[e] = (x1[e] * cs - x2[e] * sn) * sc; o2[e] = (x1[e] * sn + x2[e] * cs) * sc; }
}

__device__ __forceinline__ void attn_item(const Params& p, LAS unsigned char* lds, int item) {
  constexpr int K_OFF = 0, V_OFF = 256 * LDR, VLD = 560, PLD = 336, PWAVE = 16 * PLD;
  const int tid = opaque_tid(), wid = __builtin_amdgcn_readfirstlane(tid >> 6), lane = tid & 63, fr = lane & 15, fq = lane >> 4;
  int b, blk, h;
  if (gridDim.x == 256) { const int r = item >> 8, cidx = item & 255, x = cidx & 7, y = cidx >> 3, s = r * 8 + x;
    b = s & 1; h = ((s >> 1) & 1) * 4 + (y & 3); blk = (s >> 2) * 8 + (y >> 2); }
  else { b = item >> 8; blk = (item >> 3) & 31; h = item & 7; }
  const int kvh = h >> 2;
  const bf16_t* Z = (const bf16_t*)(p.ws + BUF_Z);
  bf16_t* MIX = (bf16_t*)(p.ws + BUF_MIX);
  const int tok0 = b * SEQ + blk * 128;
  bf16x8 Qa[4];
  {
    const bf16_t* qp = Z + (size_t)(tok0 + wid * 16 + fr) * NIN + ZC_AQ + h * 128 + fq * 8;
    float qf[4][8]; float ss = 0.f;
#pragma unroll
    for (int ks = 0; ks < 4; ++ks) { unpack8(*(const u32x4*)(qp + ks * 32), qf[ks]);
#pragma unroll
      for (int e = 0; e < 8; ++e) ss += qf[ks][e] * qf[ks][e]; }
    ss += __shfl_xor(ss, 16); ss += __shfl_xor(ss, 32);
    const float r = rsqrtf(ss * (1.0f / 128.0f) + EPS);
#pragma unroll
    for (int ks = 0; ks < 4; ++ks) { const f32x4 g0 = *(const f32x4*)(p.qn + ks * 32 + fq * 8), g1 = *(const f32x4*)(p.qn + ks * 32 + fq * 8 + 4);
      float y[8];
#pragma unroll
      for (int e = 0; e < 8; ++e) y[e] = qf[ks][e] * r * (e < 4 ? g0[e & 3] : g1[e & 3]);
      const u32x4 w = pack8(y); Qa[ks] = *(const bf16x8*)&w; }
  }
  const bool write_win = (blk == 31) && ((h & 3) == 0);
  {
    const int c = tid & 15; const f32x4 g0 = *(const f32x4*)(p.kn + c * 8), g1 = *(const f32x4*)(p.kn + c * 8 + 4);
#pragma unroll
    for (int i = 0; i < 8; ++i) {
      const int row = (tid >> 4) + 32 * i, kpos = (blk - 1) * 128 + row;
      u32x4 raw = (u32x4){0u, 0u, 0u, 0u};
      if (kpos >= 0) raw = *(const u32x4*)(Z + (size_t)(b * SEQ + kpos) * NIN + ZC_AK + kvh * 128 + c * 8);
      float f[8]; unpack8(raw, f); float ss = 0.f;
#pragma unroll
      for (int e = 0; e < 8; ++e) ss += f[e] * f[e];
      ss += __shfl_xor(ss, 1); ss += __shfl_xor(ss, 2); ss += __shfl_xor(ss, 4); ss += __shfl_xor(ss, 8);
      const float r = rsqrtf(ss * (1.0f / 128.0f) + EPS);
#pragma unroll
      for (int e = 0; e < 8; ++e) f[e] = f[e] * r * (e < 4 ? g0[e & 3] : g1[e & 3]);
      *(LAS u32x4*)(lds + K_OFF + row * LDR + c * 16) = pack8(f);
      if (write_win && row >= 128) { float* kw = p.out + O_KWP + ((size_t)(b * 128 + row - 128) * 2 + kvh) * 128 + c * 8;
        *(f32x4*)kw = (f32x4){f[0], f[1], f[2], f[3]}; *(f32x4*)(kw + 4) = (f32x4){f[4], f[5], f[6], f[7]}; }
    }
  }
  {
    const int c = tid & 15;
#pragma unroll
    for (int i = 0; i < 4; ++i) {
      const int kp = (tid >> 4) + 32 * i, j0 = 2 * kp, kpos = (blk - 1) * 128 + j0;
      u32x4 r0 = (u32x4){0u, 0u, 0u, 0u}, r1 = r0;
      if (kpos >= 0) { const bf16_t* vp = Z + (size_t)(b * SEQ + kpos) * NIN + ZC_AV + kvh * 128 + c * 8; r0 = *(const u32x4*)vp; r1 = *(const u32x4*)(vp + NIN); }
#pragma unroll
      for (int e = 0; e < 8; ++e) *(LAS unsigned*)(lds + V_OFF + (c * 8 + e) * VLD + (kp ^ (c << 2)) * 4) = half_of(r0, e) | (half_of(r1, e) << 16);
      if (write_win && j0 >= 128) { float f0[8], f1[8]; unpack8(r0, f0); unpack8(r1, f1);
        float* vw = p.out + O_VWP + ((size_t)(b * 128 + j0 - 128) * 2 + kvh) * 128 + c * 8;
        *(f32x4*)vw = (f32x4){f0[0], f0[1], f0[2], f0[3]}; *(f32x4*)(vw + 4) = (f32x4){f0[4], f0[5], f0[6], f0[7]};
        *(f32x4*)(vw + 256) = (f32x4){f1[0], f1[1], f1[2], f1[3]}; *(f32x4*)(vw + 260) = (f32x4){f1[4], f1[5], f1[6], f1[7]}; }
    }
    if (tid < 256) *(LAS u32x4*)(lds + V_OFF + (tid >> 1) * VLD + 512 + (tid & 1) * 16) = (u32x4){0u, 0u, 0u, 0u};
  }
  __syncthreads();
  f32x4 S[9];
#pragma unroll
  for (int tt = 0; tt < 9; ++tt) S[tt] = (f32x4){0.f, 0.f, 0.f, 0.f};
#pragma unroll
  for (int ks = 0; ks < 4; ++ks)
#pragma unroll
    for (int tt = 0; tt < 9; ++tt) { const bf16x8 kb = *(const LAS bf16x8*)(lds + K_OFF + ((wid + tt) * 16 + fr) * LDR + (ks * 32 + fq * 8) * 2); S[tt] = MFMA16(kb, Qa[ks], S[tt]); }
  const int qi = wid * 16 + fr; const float sink = p.sinks[h];
  float mx = sink;
#pragma unroll
  for (int tt = 0; tt < 9; ++tt)
#pragma unroll
    for (int jj = 0; jj < 4; ++jj) { const int j = (wid + tt) * 16 + fq * 4 + jj; const bool valid = (j >= qi) && (j <= qi + 128) && (blk > 0 || j >= 128);
      const float s = valid ? S[tt][jj] * ATTN_SCALE : -INFINITY; S[tt][jj] = s; mx = fmaxf(mx, s); }
  mx = fmaxf(mx, __shfl_xor(mx, 16)); mx = fmaxf(mx, __shfl_xor(mx, 32));
  float sum = 0.f;
#pragma unroll
  for (int tt = 0; tt < 9; ++tt)
#pragma unroll
    for (int jj = 0; jj < 4; ++jj) { const float e = __expf(S[tt][jj] - mx); S[tt][jj] = e; sum += e; }
  sum += __shfl_xor(sum, 16); sum += __shfl_xor(sum, 32);
  const float inv = 1.0f / (sum + __expf(sink - mx));
  __syncthreads();
  LAS unsigned char* Pw = lds + K_OFF + wid * PWAVE;
#pragma unroll
  for (int tt = 0; tt < 9; ++tt) *(LAS u32x2*)(Pw + fr * PLD + (tt * 16 + fq * 4) * 2) = (u32x2){cvt_pk_bf16(S[tt][0] * inv, S[tt][1] * inv), cvt_pk_bf16(S[tt][2] * inv, S[tt][3] * inv)};
  *(LAS u32x2*)(Pw + fr * PLD + (9 * 16 + fq * 4) * 2) = (u32x2){0u, 0u};
  __syncthreads();
  f32x4 O[8];
#pragma unroll
  for (int nt = 0; nt < 8; ++nt) O[nt] = (f32x4){0.f, 0.f, 0.f, 0.f};
#pragma unroll
  for (int ks = 0; ks < 5; ++ks) { const bf16x8 pa = *(const LAS bf16x8*)(Pw + fr * PLD + (ks * 32 + fq * 8) * 2);
#pragma unroll
    for (int nt = 0; nt < 8; ++nt) { const int kp0 = wid * 8 + ks * 16 + fq * 4, kps = kp0 < 128 ? (kp0 ^ ((nt * 2 + (fr >> 3)) << 2)) : kp0;
      const bf16x8 vb = *(const LAS bf16x8*)(lds + V_OFF + (nt * 16 + fr) * VLD + kps * 4); O[nt] = MFMA16(vb, pa, O[nt]); } }
#pragma unroll
  for (int nt = 0; nt < 8; ++nt) *(LAS u32x2*)(Pw + fr * PLD + (nt * 16 + fq * 4) * 2) = (u32x2){cvt_pk_bf16(O[nt][0], O[nt][1]), cvt_pk_bf16(O[nt][2], O[nt][3])};
  wave_store_rows16(Pw, PLD, MIX + (size_t)(tok0 + wid * 16) * DM + h * 128, DM, lane);
  __syncthreads();
}

__device__ __forceinline__ void stage_vt128(const bf16_t* Z, int tok0, int col, LAS unsigned char* dst) {
  const int tid = opaque_tid(), c = tid & 15;
#pragma unroll
  for (int i = 0; i < 2; ++i) { const int kp = (tid >> 4) + 32 * i; const bf16_t* vp = Z + (size_t)(tok0 + 2 * kp) * NIN + col + c * 8;
    const u32x4 r0 = *(const u32x4*)vp, r1 = *(const u32x4*)(vp + NIN);
#pragma unroll
    for (int e = 0; e < 8; ++e) *(LAS unsigned*)(dst + (c * 8 + e) * LDR + (kp ^ (c << 2)) * 4) = half_of(r0, e) | (half_of(r1, e) << 16); }
}
__device__ __forceinline__ void retkv_item(const Params& p, LAS unsigned char* lds, int item) {
  constexpr int KT_OFF = 0, VT_OFF = 128 * LDR;
  const int tid = opaque_tid(), wid = __builtin_amdgcn_readfirstlane(tid >> 6), lane = tid & 63, fr = lane & 15, fq = lane >> 4;
  const int bh = item >> 5, c = item & 31, b = bh >> 3, h = bh & 7;
  const bf16_t* Z = (const bf16_t*)(p.ws + BUF_Z);
  const float* rc = (const float*)(p.ws + BUF_ROPE); const float* rsn = rc + 4097 * 64;
  bf16_t* KV = (bf16_t*)(p.ws + BUF_KV16);
  const int tok0 = b * SEQ + c * 128; const float lg = ret_lg(h);
  {
    const int cc = tid & 7, kp = tid >> 3, n0 = 2 * kp;
    float a1[8], a2[8], b1[8], b2[8];
    rot16(Z + (size_t)(tok0 + n0) * NIN + ZC_RK + h * 128, cc, rc, rsn, c * 128 + n0, RET_K_SCALE * __expf(lg * (float)(127 - n0)), a1, a2);
    rot16(Z + (size_t)(tok0 + n0 + 1) * NIN + ZC_RK + h * 128, cc, rc, rsn, c * 128 + n0 + 1, RET_K_SCALE * __expf(lg * (float)(126 - n0)), b1, b2);
#pragma unroll
    for (int e = 0; e < 8; ++e) { *(LAS unsigned*)(lds + KT_OFF + (cc * 8 + e) * LDR + (kp ^ (cc << 3)) * 4) = cvt_pk_bf16(a1[e], b1[e]);
      *(LAS unsigned*)(lds + KT_OFF + (64 + cc * 8 + e) * LDR + (kp ^ (cc << 3)) * 4) = cvt_pk_bf16(a2[e], b2[e]); }
  }
  stage_vt128(Z, tok0, ZC_RV + h * 128, lds + VT_OFF);
  __syncthreads();
  f32x4 acc[8];
#pragma unroll
  for (int nt = 0; nt < 8; ++nt) acc[nt] = (f32x4){0.f, 0.f, 0.f, 0.f};
#pragma unroll
  for (int ks = 0; ks < 4; ++ks) { const int kp0 = ks * 16 + fq * 4;
    const bf16x8 a = *(const LAS bf16x8*)(lds + KT_OFF + (wid * 16 + fr) * LDR + (kp0 ^ (((wid * 2 + (fr >> 3)) & 7) << 3)) * 4);
#pragma unroll
    for (int nt = 0; nt < 8; ++nt) { const bf16x8 vb = *(const LAS bf16x8*)(lds + VT_OFF + (nt * 16 + fr) * LDR + (kp0 ^ ((nt * 2 + (fr >> 3)) << 2)) * 4); acc[nt] = MFMA16(vb, a, acc[nt]); } }
  LAS unsigned char* wb = lds + KT_OFF + (wid * 16) * LDR;
#pragma unroll
  for (int nt = 0; nt < 8; ++nt) *(LAS u32x2*)(wb + fr * LDR + (nt * 16 + fq * 4) * 2) = (u32x2){cvt_pk_bf16(acc[nt][0], acc[nt][1]), cvt_pk_bf16(acc[nt][2], acc[nt][3])};
  wave_store_rows16(wb, LDR, KV + (size_t)item * 16384 + (wid * 16) * 128, 128, lane);
  __syncthreads();
}

__device__ __forceinline__ void phase_scan(const Params& p) {
  const unsigned* KV = (const unsigned*)(p.ws + BUF_KV16);
  const size_t gtid = (size_t)blockIdx.x * 512 + threadIdx.x, gstride = (size_t)gridDim.x * 512;
  for (size_t idx = gtid; idx < (size_t)16 * 8192; idx += gstride) {
    const int bh = (int)(idx >> 13), e2 = (int)(idx & 8191), h = bh & 7;
    const float dec = __expf(ret_lg(h) * 128.0f);
    const unsigned* base = KV + (size_t)bh * 32 * 8192 + e2; unsigned* s16 = (unsigned*)(p.ws + BUF_S16) + (size_t)bh * 32 * 8192 + e2;
    unsigned v[32];
#pragma unroll
    for (int c = 0; c < 32; ++c) v[c] = base[(size_t)c * 8192];
    f32x2v s = (f32x2v){0.f, 0.f};
#pragma unroll
    for (int c = 0; c < 32; ++c) { s16[(size_t)c * 8192] = cvt_pk_bf16(s[0], s[1]); s = s * dec + (f32x2v){bf_lo(v[c]), bf_hi(v[c])}; }
    *(f32x2v*)(p.out + O_RSP + (size_t)bh * 16384 + e2 * 2) = s;
  }
}

__device__ __forceinline__ void retout_item(const Params& p, LAS unsigned char* lds, int item) {
  constexpr int Q_OFF = 0, K_OFF = 128 * LDR, VT_OFF = 256 * LDR, ST_OFF = 384 * LDR;
  const int tid = opaque_tid(), wid = __builtin_amdgcn_readfirstlane(tid >> 6), lane = tid & 63, fr = lane & 15, fq = lane >> 4;
  const int bh = item >> 5, c = item & 31, b = bh >> 3, h = bh & 7;
  const bf16_t* Z = (const bf16_t*)(p.ws + BUF_Z);
  bf16_t* MIX = (bf16_t*)(p.ws + BUF_MIX);
  const float* rc = (const float*)(p.ws + BUF_ROPE); const float* rsn = rc + 4097 * 64;
  const bf16_t* SP = (const bf16_t*)(p.ws + BUF_S16) + (size_t)item * 16384;
  const int tok0 = b * SEQ + c * 128; const float lg = ret_lg(h);
  {
    const int cc = tid & 7;
#pragma unroll
    for (int i = 0; i < 2; ++i) { const int n = (tid >> 3) + 64 * i; float o1[8], o2[8];
      rot16(Z + (size_t)(tok0 + n) * NIN + ZC_RQ + h * 128, cc, rc, rsn, c * 128 + n, 1.0f, o1, o2);
      *(LAS u32x4*)(lds + Q_OFF + n * LDR + cc * 16) = pack8(o1); *(LAS u32x4*)(lds + Q_OFF + n * LDR + (cc + 8) * 16) = pack8(o2);
      rot16(Z + (size_t)(tok0 + n) * NIN + ZC_RK + h * 128, cc, rc, rsn, c * 128 + n, RET_K_SCALE, o1, o2);
      *(LAS u32x4*)(lds + K_OFF + n * LDR + cc * 16) = pack8(o1); *(LAS u32x4*)(lds + K_OFF + n * LDR + (cc + 8) * 16) = pack8(o2); }
  }
  stage_vt128(Z, tok0, ZC_RV + h * 128, lds + VT_OFF);
  {
    const int c16 = tid & 15;
#pragma unroll
    for (int i = 0; i < 2; ++i) { const int kp = (tid >> 4) + 32 * i; const bf16_t* sp = SP + (size_t)(2 * kp) * 128 + c16 * 8;
      const u32x4 r0 = *(const u32x4*)sp, r1 = *(const u32x4*)(sp + 128);
#pragma unroll
      for (int e = 0; e < 8; ++e) *(LAS unsigned*)(lds + ST_OFF + (c16 * 8 + e) * LDR + (kp ^ (c16 << 2)) * 4) = half_of(r0, e) | (half_of(r1, e) << 16); }
  }
  __syncthreads();
  const int n = wid * 16 + fr;
  bf16x8 Qa[4];
#pragma unroll
  for (int ks = 0; ks < 4; ++ks) Qa[ks] = *(const LAS bf16x8*)(lds + Q_OFF + n * LDR + (ks * 32 + fq * 8) * 2);
  f32x4 O[8];
#pragma unroll
  for (int nt = 0; nt < 8; ++nt) O[nt] = (f32x4){0.f, 0.f, 0.f, 0.f};
#pragma unroll
  for (int ks = 0; ks < 4; ++ks)
#pragma unroll
    for (int nt = 0; nt < 8; ++nt) { const bf16x8 sb = *(const LAS bf16x8*)(lds + ST_OFF + (nt * 16 + fr) * LDR + ((ks * 16 + fq * 4) ^ ((nt * 2 + (fr >> 3)) << 2)) * 4); O[nt] = MFMA16(sb, Qa[ks], O[nt]); }
  const float qdec = __expf(lg * (float)(n + 1));
#pragma unroll
  for (int nt = 0; nt < 8; ++nt) O[nt] *= qdec;
  f32x4 SC[8];
#pragma unroll
  for (int tt = 0; tt < 8; ++tt) { SC[tt] = (f32x4){0.f, 0.f, 0.f, 0.f};
    if (tt <= wid) {
#pragma unroll
      for (int ks = 0; ks < 4; ++ks) { const bf16x8 kb = *(const LAS bf16x8*)(lds + K_OFF + (tt * 16 + fr) * LDR + (ks * 32 + fq * 8) * 2); SC[tt] = MFMA16(kb, Qa[ks], SC[tt]); } } }
  __syncthreads();
#pragma unroll
  for (int tt = 0; tt < 8; ++tt) { float pv[4];
#pragma unroll
    for (int jj = 0; jj < 4; ++jj) { const int e = tt * 16 + fq * 4 + jj; pv[jj] = (e <= n) ? SC[tt][jj] * __expf(lg * (float)(n - e)) : 0.f; }
    *(LAS u32x2*)(lds + K_OFF + n * LDR + (tt * 16 + fq * 4) * 2) = (u32x2){cvt_pk_bf16(pv[0], pv[1]), cvt_pk_bf16(pv[2], pv[3])}; }
  __syncthreads();
#pragma unroll
  for (int ks = 0; ks < 4; ++ks) { const bf16x8 pa = *(const LAS bf16x8*)(lds + K_OFF + n * LDR + (ks * 32 + fq * 8) * 2);
#pragma unroll
    for (int nt = 0; nt < 8; ++nt) { const bf16x8 vb = *(const LAS bf16x8*)(lds + VT_OFF + (nt * 16 + fr) * LDR + ((ks * 16 + fq * 4) ^ ((nt * 2 + (fr >> 3)) << 2)) * 4); O[nt] = MFMA16(vb, pa, O[nt]); } }
  float ss = 0.f;
#pragma unroll
  for (int nt = 0; nt < 8; ++nt) ss += O[nt][0] * O[nt][0] + O[nt][1] * O[nt][1] + O[nt][2] * O[nt][2] + O[nt][3] * O[nt][3];
  ss += __shfl_xor(ss, 16); ss += __shfl_xor(ss, 32);
  const float r = rsqrtf(ss * (1.0f / 128.0f) + EPS);
  LAS unsigned char* wb = lds + K_OFF + (wid * 16) * LDR;
  u32x4 graw[4];
#pragma unroll
  for (int i = 0; i < 4; ++i) graw[i] = *(const u32x4*)(Z + (size_t)(tok0 + wid * 16 + (lane >> 4) + 4 * i) * NIN + ZC_RG + h * 128 + (lane & 15) * 8);
#pragma unroll
  for (int nt = 0; nt < 8; ++nt) { const f32x4 rg = *(const f32x4*)(p.rg + h * 128 + nt * 16 + fq * 4);
    *(LAS u32x2*)(wb + fr * LDR + (nt * 16 + fq * 4) * 2) = (u32x2){cvt_pk_bf16(O[nt][0] * r * rg[0], O[nt][1] * r * rg[1]), cvt_pk_bf16(O[nt][2] * r * rg[2], O[nt][3] * r * rg[3])}; }
#pragma unroll
  for (int i = 0; i < 4; ++i) { const int row = (lane >> 4) + 4 * i, ch = lane & 15;
    float y[8], g[8]; unpack8(*(const LAS u32x4*)(wb + row * LDR + ch * 16), y); unpack8(graw[i], g);
#pragma unroll
    for (int e2 = 0; e2 < 8; ++e2) y[e2] *= silu_f(g[e2]);
    *(u32x4*)(MIX + (size_t)(tok0 + wid * 16 + row) * DM + 1024 + h * 128 + ch * 8) = pack8(y); }
  __syncthreads();
}
__device__ __forceinline__ void sample_item(const Params& p, LAS unsigned char* lds, int item) {
  const int tid = opaque_tid(), wid = __builtin_amdgcn_readfirstlane(tid >> 6), lane = tid & 63;
  int b, h;
  if (gridDim.x == 256) { const int x = item & 7, y = item >> 3, g = x * 8 + (y >> 2); b = g >> 1; h = (g & 1) * 4 + (y & 3); }
  else { b = item >> 3; h = item & 7; }
  const int kvh = h >> 2, R = NTOK_P + b;
  const bf16_t* zr = (const bf16_t*)(p.ws + BUF_Z) + (size_t)R * NIN;
  bf16_t* mixr = (bf16_t*)(p.ws + BUF_MIX) + (size_t)R * DM;
  LAS float* qs = (LAS float*)lds; LAS float* ks = qs + 128; LAS float* vs = qs + 256; LAS float* sc = qs + 384; LAS float* pr = qs + 528; LAS float* part = qs + 672;
  LAS float* qr = qs + 2720; LAS float* kr = qr + 128; LAS float* vv = qr + 256; LAS float* gg = qr + 384;
  const float* rc = (const float*)(p.ws + BUF_ROPE) + 4096 * 64; const float* rsn = rc + 4097 * 64;
  if (wid == 0) { const float a0 = bf2f(zr[ZC_AQ + h * 128 + lane]), a1 = bf2f(zr[ZC_AQ + h * 128 + lane + 64]); const float r = rsqrtf(wave_sum(a0 * a0 + a1 * a1) * (1.0f / 128.0f) + EPS);
    qs[lane] = a0 * r * p.qn[lane]; qs[lane + 64] = a1 * r * p.qn[lane + 64]; }
  else if (wid == 1) { const float a0 = bf2f(zr[ZC_AK + kvh * 128 + lane]), a1 = bf2f(zr[ZC_AK + kvh * 128 + lane + 64]); const float r = rsqrtf(wave_sum(a0 * a0 + a1 * a1) * (1.0f / 128.0f) + EPS);
    ks[lane] = a0 * r * p.kn[lane]; ks[lane + 64] = a1 * r * p.kn[lane + 64]; }
  else if (wid == 2) { vs[lane] = bf2f(zr[ZC_AV + kvh * 128 + lane]); vs[lane + 64] = bf2f(zr[ZC_AV + kvh * 128 + lane + 64]); }
  else if (wid == 3) { const float x1 = bf2f(zr[ZC_RQ + h * 128 + lane]), x2 = bf2f(zr[ZC_RQ + h * 128 + lane + 64]); const float cs = rc[lane], sn = rsn[lane];
    qr[lane] = x1 * cs - x2 * sn; qr[lane + 64] = x1 * sn + x2 * cs; }
  else if (wid == 4) { const float x1 = bf2f(zr[ZC_RK + h * 128 + lane]), x2 = bf2f(zr[ZC_RK + h * 128 + lane + 64]); const float cs = rc[lane], sn = rsn[lane];
    kr[lane] = (x1 * cs - x2 * sn) * RET_K_SCALE; kr[lane + 64] = (x1 * sn + x2 * cs) * RET_K_SCALE; }
  else if (wid == 5) { vv[lane] = bf2f(zr[ZC_RV + h * 128 + lane]); vv[lane + 64] = bf2f(zr[ZC_RV + h * 128 + lane + 64]); }
  else if (wid == 6) { gg[lane] = bf2f(zr[ZC_RG + h * 128 + lane]); gg[lane + 64] = bf2f(zr[ZC_RG + h * 128 + lane + 64]); }
  __syncthreads();
  {
    const int ch = lane & 31, hf = lane >> 5;
    const f32x4 qv = (f32x4){qs[ch * 4], qs[ch * 4 + 1], qs[ch * 4 + 2], qs[ch * 4 + 3]};
    f32x4 kvv[8];
#pragma unroll
    for (int i = 0; i < 8; ++i) kvv[i] = *(const f32x4*)(p.ck + ((size_t)(b * 128 + wid * 16 + i * 2 + hf) * 2 + kvh) * 128 + ch * 4);
#pragma unroll
    for (int i = 0; i < 8; ++i) { float dd = kvv[i][0] * qv[0] + kvv[i][1] * qv[1] + kvv[i][2] * qv[2] + kvv[i][3] * qv[3];
      dd += __shfl_xor(dd, 1); dd += __shfl_xor(dd, 2); dd += __shfl_xor(dd, 4); dd += __shfl_xor(dd, 8); dd += __shfl_xor(dd, 16);
      if (ch == 0) sc[wid * 16 + i * 2 + hf] = dd * ATTN_SCALE; }
    if (wid == 0) { const float dn = wave_sum(qs[lane] * ks[lane] + qs[lane + 64] * ks[lane + 64]); if (lane == 0) sc[128] = dn * ATTN_SCALE; }
  }
  __syncthreads();
  if (wid == 0) { const float sink = p.sinks[h]; const float s0 = sc[lane], s1 = sc[lane + 64], s2 = lane == 0 ? sc[128] : -INFINITY;
    const float mx = fmaxf(wave_max(fmaxf(fmaxf(s0, s1), s2)), sink);
    const float e0 = __expf(s0 - mx), e1 = __expf(s1 - mx), e2 = __expf(s2 - mx);
    const float inv = 1.0f / (wave_sum(e0 + e1 + e2) + __expf(sink - mx));
    pr[lane] = e0 * inv; pr[lane + 64] = e1 * inv; if (lane == 0) pr[128] = e2 * inv; }
  __syncthreads();
  {
    const int ch = lane & 31, hf = lane >> 5;
    f32x4 vvv[8];
#pragma unroll
    for (int i = 0; i < 8; ++i) vvv[i] = *(const f32x4*)(p.cv + ((size_t)(b * 128 + wid * 16 + i * 2 + hf) * 2 + kvh) * 128 + ch * 4);
    f32x4 a4 = (f32x4){0.f, 0.f, 0.f, 0.f};
#pragma unroll
    for (int i = 0; i < 8; ++i) a4 += vvv[i] * pr[wid * 16 + i * 2 + hf];
#pragma unroll
    for (int j = 0; j < 4; ++j) a4[j] += __shfl_xor(a4[j], 32);
    if (hf == 0) { part[wid * 128 + ch * 4] = a4[0]; part[wid * 128 + ch * 4 + 1] = a4[1]; part[wid * 128 + ch * 4 + 2] = a4[2]; part[wid * 128 + ch * 4 + 3] = a4[3]; }
  }
  __syncthreads();
  if (tid < 128) { float o = pr[128] * vs[tid];
#pragma unroll
    for (int w = 0; w < 8; ++w) o += part[w * 128 + tid];
    mixr[h * 128 + tid] = (bf16_t)(cvt_pk_bf16(o, 0.f) & 0xffffu); }
  if ((h & 3) == 0) {
    for (int idx = tid; idx < 128 * 32; idx += 512) { const int w = idx >> 5, d4 = (idx & 31) * 4;
      const size_t src = ((size_t)(b * 128 + w + 1) * 2 + kvh) * 128 + d4, dst = ((size_t)(b * 128 + w) * 2 + kvh) * 128 + d4;
      f32x4 kx, vx;
      if (w < 127) { kx = *(const f32x4*)(p.ck + src); vx = *(const f32x4*)(p.cv + src); }
      else { kx = (f32x4){ks[d4], ks[d4 + 1], ks[d4 + 2], ks[d4 + 3]}; vx = (f32x4){vs[d4], vs[d4 + 1], vs[d4 + 2], vs[d4 + 3]}; }
      __builtin_nontemporal_store(kx, (f32x4*)(p.out + O_KWS + dst)); __builtin_nontemporal_store(vx, (f32x4*)(p.out + O_VWS + dst)); }
  }
  __syncthreads();
  {
    const float gamma = 1.0f - exp2f(-5.0f - (float)h);
    const int dv4 = (tid & 31) * 4, dkg = tid >> 5;
    const f32x4 v4 = (f32x4){vv[dv4], vv[dv4 + 1], vv[dv4 + 2], vv[dv4 + 3]};
    f32x4 o4 = (f32x4){0.f, 0.f, 0.f, 0.f};
#pragma unroll
    for (int i = 0; i < 8; ++i) { const int dk = dkg + 16 * i; const size_t off = ((size_t)(b * 8 + h) * 128 + dk) * 128 + dv4;
      const f32x4 sn = __builtin_nontemporal_load((const f32x4*)(p.st + off)) * gamma + v4 * kr[dk];
      __builtin_nontemporal_store(sn, (f32x4*)(p.out + O_RSS + off)); o4 += sn * qr[dk]; }
    part[dkg * 128 + dv4] = o4[0]; part[dkg * 128 + dv4 + 1] = o4[1]; part[dkg * 128 + dv4 + 2] = o4[2]; part[dkg * 128 + dv4 + 3] = o4[3];
  }
  __syncthreads();
  if (wid == 0) { float o0 = 0.f, o1 = 0.f;
#pragma unroll
    for (int g = 0; g < 16; ++g) { o0 += part[g * 128 + lane]; o1 += part[g * 128 + lane + 64]; }
    const float r = rsqrtf(wave_sum(o0 * o0 + o1 * o1) * (1.0f / 128.0f) + EPS);
    const float y0 = o0 * r * p.rg[h * 128 + lane] * silu_f(gg[lane]), y1 = o1 * r * p.rg[h * 128 + lane + 64] * silu_f(gg[lane + 64]);
    mixr[1024 + h * 128 + lane] = (bf16_t)(cvt_pk_bf16(y0, 0.f) & 0xffffu); mixr[1024 + h * 128 + lane + 64] = (bf16_t)(cvt_pk_bf16(y1, 0.f) & 0xffffu); }
  __syncthreads();
}


template <int NB, int U>
__device__ __forceinline__ void skinny_mma(const bf16_t* A, const bf16_t* B0, const bf16_t* B1, int K, LAS float* red, float (&out)[NB]) {
  const int tid = opaque_tid(), wid = __builtin_amdgcn_readfirstlane(tid >> 6), lane = tid & 63, fr = lane & 15, fq = lane >> 4;
  const int kw = K >> 3, nks = kw >> 5;
  f32x4 acc[NB][2];
#pragma unroll
  for (int nb = 0; nb < NB; ++nb) { acc[nb][0] = (f32x4){0.f, 0.f, 0.f, 0.f}; acc[nb][1] = (f32x4){0.f, 0.f, 0.f, 0.f}; }
  const size_t off = (size_t)fr * K + wid * kw + fq * 8;
  const bf16_t* a0p = A + off; const bf16_t* a1p = a0p + (size_t)16 * K; const bf16_t* b0p = B0 + off; const bf16_t* b1p = B1 + off;
  for (int ks0 = 0; ks0 < nks; ks0 += U) {
    bf16x8 a0[U], a1[U], b0[U], b1[U];
#pragma unroll
    for (int u = 0; u < U; ++u) { a0[u] = *(const bf16x8*)(a0p + (ks0 + u) * 32); a1[u] = *(const bf16x8*)(a1p + (ks0 + u) * 32); b0[u] = *(const bf16x8*)(b0p + (ks0 + u) * 32);
      if (NB == 2) b1[u] = *(const bf16x8*)(b1p + (ks0 + u) * 32); else b1[u] = b0[u]; }
#pragma unroll
    for (int u = 0; u < U; ++u) { acc[0][0] = MFMA16(b0[u], a0[u], acc[0][0]); acc[0][1] = MFMA16(b0[u], a1[u], acc[0][1]);
      if (NB == 2) { acc[NB - 1][0] = MFMA16(b1[u], a0[u], acc[NB - 1][0]); acc[NB - 1][1] = MFMA16(b1[u], a1[u], acc[NB - 1][1]); } }
  }
#pragma unroll
  for (int nb = 0; nb < NB; ++nb)
#pragma unroll
    for (int hf = 0; hf < 2; ++hf) *(LAS f32x4*)(red + ((nb * 8 + wid) * 32 + hf * 16 + fr) * 16 + fq * 4) = acc[nb][hf];
  __syncthreads();
  const int row = tid >> 4, col = tid & 15;
#pragma unroll
  for (int nb = 0; nb < NB; ++nb) { float s = 0.f;
#pragma unroll
    for (int w = 0; w < 8; ++w) s += red[((nb * 8 + w) * 32 + row) * 16 + col];
    out[nb] = s; }
  __syncthreads();
}
#define SKINNY_LOOP(ntasks, nwg) const int _r = (nwg) % G, _nb = _r ? G - _r : G; const int _me = G - 1 - bid; if (_me < _nb) for (int task = _me; task < (ntasks); task += _nb)

__device__ __forceinline__ void skinny_p1(const Params& p, LAS unsigned char* lds, int G, int bid) {
  unsigned char* ws = p.ws; const int tid = opaque_tid(), row = tid >> 4, col = tid & 15;
  SKINNY_LOOP(NIN / 16, (NTOK_P / 256) * (NIN / 256)) { const int c0 = task * 16; float v[1];
    skinny_mma<1, 8>((const bf16_t*)(ws + BUF_A) + (size_t)NTOK_P * DM, (const bf16_t*)(ws + W_IN) + (size_t)c0 * DM, nullptr, DM, (LAS float*)lds, v);
    ((bf16_t*)(ws + BUF_Z))[(size_t)(NTOK_P + row) * NIN + c0 + col] = (bf16_t)(cvt_pk_bf16(v[0], 0.f) & 0xffffu); }
}
__device__ __forceinline__ void skinny_p3(const Params& p, LAS unsigned char* lds, int G, int bid) {
  unsigned char* ws = p.ws; const int tid = opaque_tid(), row = tid >> 4, col = tid & 15; float* rs1 = (float*)(ws + BUF_RS);
  SKINNY_LOOP(DM / 16, (NTOK_P / 256) * (DM / 256)) { const int c = task * 16 + col; float v[1];
    skinny_mma<1, 8>((const bf16_t*)(ws + BUF_MIX) + (size_t)NTOK_P * DM, (const bf16_t*)(ws + W_OUT) + (size_t)(task * 16) * DM, nullptr, DM, (LAS float*)lds, v);
    const float hn = p.x_s[(size_t)row * DM + c] + v[0];
    ((bf16_t*)(ws + BUF_B))[(size_t)(NTOK_P + row) * DM + c] = (bf16_t)(cvt_pk_bf16(hn * p.fn[c], 0.f) & 0xffffu);
    float ss = hn * hn; ss += __shfl_xor(ss, 1); ss += __shfl_xor(ss, 2); ss += __shfl_xor(ss, 4); ss += __shfl_xor(ss, 8);
    if (col == 0) atomicAdd(rs1 + NTOK_P + row, ss); }
}
__device__ __forceinline__ void skinny_p5(const Params& p, LAS unsigned char* lds, int G, int bid) {
  unsigned char* ws = p.ws; const int tid = opaque_tid(), row = tid >> 4, col = tid & 15; float* rs2 = (float*)(ws + BUF_RS) + M_PAD;
  SKINNY_LOOP(DM / 16, (NTOK_P / 256) * (DM / 256)) { const int c = task * 16 + col; float v[1];
    skinny_mma<1, 11>((const bf16_t*)(ws + BUF_Z) + (size_t)NTOK_P * DFF, (const bf16_t*)(ws + W_DOWN) + (size_t)(task * 16) * DFF, nullptr, DFF, (LAS float*)lds, v);
    const float hn = bf2f(((const bf16_t*)(ws + BUF_B))[(size_t)(NTOK_P + row) * DM + c]) / p.fn[c] + v[0];
    ((bf16_t*)(ws + BUF_A))[(size_t)(NTOK_P + row) * DM + c] = (bf16_t)(cvt_pk_bf16(hn * p.pn[c], 0.f) & 0xffffu);
    float ss = hn * hn; ss += __shfl_xor(ss, 1); ss += __shfl_xor(ss, 2); ss += __shfl_xor(ss, 4); ss += __shfl_xor(ss, 8);
    if (col == 0) atomicAdd(rs2 + NTOK_P + row, ss); }
}
__device__ __forceinline__ void skinny_p4(const Params& p, LAS unsigned char* lds, int G, int bid) {
  unsigned char* ws = p.ws; const int tid = opaque_tid(), row = tid >> 4, col = tid & 15; const float* rs1 = (const float*)(ws + BUF_RS);
  SKINNY_LOOP(DFF / 16, (NTOK_P / 256) * (2 * DFF / 256)) { const int c0 = task * 16, gr = (c0 >> 7) * 256 + (c0 & 127); float v[2];
    skinny_mma<2, 8>((const bf16_t*)(ws + BUF_B) + (size_t)NTOK_P * DM, (const bf16_t*)(ws + W_GU) + (size_t)gr * DM, (const bf16_t*)(ws + W_GU) + (size_t)(gr + 128) * DM, DM, (LAS float*)lds, v);
    const float r = rsqrtf(rs1[NTOK_P + row] * (1.0f / DM) + EPS);
    ((bf16_t*)(ws + BUF_Z))[(size_t)(NTOK_P + row) * DFF + c0 + col] = (bf16_t)(cvt_pk_bf16(silu_f(v[0] * r) * (v[1] * r), 0.f) & 0xffffu); }
}
__device__ __forceinline__ void skinny_p6(const Params& p, LAS unsigned char* lds, int G, int bid) {
  unsigned char* ws = p.ws; const int tid = opaque_tid(), row = tid >> 4, col = tid & 15; const float* rs2 = (const float*)(ws + BUF_RS) + M_PAD;
  SKINNY_LOOP(DM / 16, (NTOK_P / 256) * (DM / 256)) { const int c0 = task * 16; float v[1], t[1];
    skinny_mma<1, 8>((const bf16_t*)(ws + BUF_A) + (size_t)NTOK_P * DM, (const bf16_t*)(ws + W_PG) + (size_t)c0 * DM, nullptr, DM, (LAS float*)lds, v);
    skinny_mma<1, 1>((const bf16_t*)(ws + BUF_P) + (size_t)NTOK_P * PLE, (const bf16_t*)(ws + W_PLE) + (size_t)c0 * PLE, nullptr, PLE, (LAS float*)lds, t);
    const float r = rsqrtf(rs2[NTOK_P + row] * (1.0f / DM) + EPS);
    const int c = c0 + col; const float h2 = bf2f(((const bf16_t*)(ws + BUF_A))[(size_t)(NTOK_P + row) * DM + c]) / p.pn[c];
    p.out[O_YS + (size_t)row * DM + c] = h2 + t[0] * sigmoid_f(v[0] * r); }
}

__device__ __forceinline__ void tail_wout(const Params& p, LAS unsigned char* lds, int G, int bid) {
  const int r = ((NTOK_P / 256) * (NIN / 256)) % G, nb = r ? G - r : G, me = G - 1 - bid;
  if (me < nb) transpose_jobs<1>(p, lds, me, nb);
}
__device__ __forceinline__ void tail_wdown(const Params& p, LAS unsigned char* lds, int G, int bid) {
  const int r = ((NTOK_P / 256) * (2 * DFF / 256)) % G, nb = r ? G - r : G, me = G - 1 - bid;
  if (me < nb) transpose_jobs<2>(p, lds, me, nb);
}

__global__ void __launch_bounds__(512, 2) hybrid_fwd(Params p) {
  extern __shared__ __attribute__((aligned(16))) unsigned char shm[];
  cg::grid_group grid = cg::this_grid();
  LAS unsigned char* lds = (LAS unsigned char*)shm;
  unsigned char* ws = p.ws;
  const int G = (int)gridDim.x, bid = (int)blockIdx.x;
  bf16_t* bufA = (bf16_t*)(ws + BUF_A); bf16_t* bufB = (bf16_t*)(ws + BUF_B); bf16_t* bufZ = (bf16_t*)(ws + BUF_Z);
  float* rs1 = (float*)(ws + BUF_RS); float* rs2 = rs1 + M_PAD;
  volatile LAS unsigned* st = (volatile LAS unsigned*)(lds + LDS_PHASE_BYTES);
  if (threadIdx.x == 0) { st[0] = 0u; st[1] = 0u; }
  __syncthreads();
  const XcdBarrier xb = xcd_barrier_post((unsigned*)(ws + BUF_BAR), st);

  phase_prep(p, lds);
  if (p.never) grid.sync();
  xcd_barrier(xb);
  { Gemm g{bufA, (const bf16_t*)(ws + W_IN), NTOK_P, NIN, DM}; StaticOrder S; S.init(NTOK_P, NIN, G, bid); EpiZ E{bufZ, NIN};
    gemm_phase<EpiZ, StaticOrder, false>(lds, g, S, E, nullptr); }
  skinny_p1(p, lds, G, bid);
  tail_wout(p, lds, G, bid);
  xcd_barrier(xb);
  for (int it = bid; it < 1280; it += G) { if (it < 512) attn_item(p, lds, it); else if (it < 1024) retkv_item(p, lds, it - 512); else sample_item(p, lds, it - 1024); }
  xcd_barrier(xb);
  phase_scan(p);
  xcd_barrier(xb);
  for (int it = bid; it < 512; it += G) retout_item(p, lds, it);
  xcd_barrier(xb);
  { Gemm g{(const bf16_t*)(ws + BUF_MIX), (const bf16_t*)(ws + W_OUT), NTOK_P, DM, DM}; StaticOrder S; S.init(NTOK_P, DM, G, bid); EpiRes3 E{bufA, (const float*)(ws + BUF_XS), p.an, bufB, p.fn, rs1};
    gemm_phase<EpiRes3, StaticOrder, false>(lds, g, S, E, nullptr); }
  skinny_p3(p, lds, G, bid);
  xcd_barrier(xb);
  { Gemm g{bufB, (const bf16_t*)(ws + W_GU), NTOK_P, 2 * DFF, DM}; StaticOrder S; S.init(NTOK_P, 2 * DFF, G, bid); EpiAct E{bufZ, rs1};
    gemm_phase<EpiAct, StaticOrder, false>(lds, g, S, E, nullptr); }
  skinny_p4(p, lds, G, bid);
  tail_wdown(p, lds, G, bid);
  xcd_barrier(xb);
  { Gemm g{bufZ, (const bf16_t*)(ws + W_DOWN), NTOK_P, DM, DFF}; StaticOrder S; S.init(NTOK_P, DM, G, bid); EpiRes5 E{bufB, p.fn, bufA, p.pn, rs2};
    gemm_phase<EpiRes5, StaticOrder, false>(lds, g, S, E, nullptr); }
  { Gemm g{(const bf16_t*)(ws + BUF_P), (const bf16_t*)(ws + W_PLE), NTOK_P, DM, PLE}; StaticOrder S; S.init(NTOK_P, DM, G, bid); EpiZ E{bufB, DM};
    gemm_phase<EpiZ, StaticOrder, false>(lds, g, S, E, nullptr); }
  skinny_p5(p, lds, G, bid);
  xcd_barrier(xb);
  { Gemm g{bufA, (const bf16_t*)(ws + W_PG), NTOK_P, DM, DM}; StaticOrder S; S.init(NTOK_P, DM, G, bid); EpiPle E{p.out, bufA, p.pn, bufB, rs2};
    gemm_phase<EpiPle, StaticOrder, false>(lds, g, S, E, nullptr); }
  skinny_p6(p, lds, G, bid);
}

extern "C" void kernel_launch(void* const* d_in, const int* in_sizes, int n_in, void* d_out, int out_size, void* d_ws, size_t ws_size, hipStream_t stream) {
  static int grid_blocks = 0;
  if (!grid_blocks) {
    int dev = 0, cus = 0, per_cu = 0;
    (void)hipGetDevice(&dev);
    (void)hipDeviceGetAttribute(&cus, hipDeviceAttributeMultiprocessorCount, dev);
    (void)hipFuncSetAttribute((const void*)hybrid_fwd, hipFuncAttributeMaxDynamicSharedMemorySize, LDS_BYTES);
    (void)hipOccupancyMaxActiveBlocksPerMultiprocessor(&per_cu, hybrid_fwd, 512, (size_t)LDS_BYTES);
    if (per_cu < 1) per_cu = 1;
    grid_blocks = cus * per_cu;
    if (ws_size < WS_END) fprintf(stderr, "workspace too small: %zu < %zu\n", ws_size, (size_t)WS_END);
  }
  Params p{};
  p.x_p = (const float*)d_in[0]; p.x_s = (const float*)d_in[1]; p.ck = (const float*)d_in[2]; p.cv = (const float*)d_in[3]; p.st = (const float*)d_in[4];
  p.p_p = (const float*)d_in[5]; p.p_s = (const float*)d_in[6]; p.an = (const float*)d_in[7]; p.w_in = (const float*)d_in[8]; p.qn = (const float*)d_in[9];
  p.kn = (const float*)d_in[10]; p.sinks = (const float*)d_in[11]; p.rg = (const float*)d_in[12]; p.w_out = (const float*)d_in[13]; p.fn = (const float*)d_in[14];
  p.w_gate = (const float*)d_in[15]; p.w_up = (const float*)d_in[16]; p.w_down = (const float*)d_in[17]; p.pn = (const float*)d_in[18]; p.w_ple = (const float*)d_in[19];
  p.w_pg = (const float*)d_in[20]; p.out = (float*)d_out; p.ws = (unsigned char*)d_ws;
  (void)hipMemsetAsync((unsigned char*)d_ws + BUF_BAR, 0, (size_t)XCD_BAR_WORDS * 4, stream);
  void* args[] = {&p};
  hipError_t e = hipLaunchCooperativeKernel((const void*)hybrid_fwd, dim3(grid_blocks), dim3(512), args, (size_t)LDS_BYTES, stream);
  if (e != hipSuccess) fprintf(stderr, "cooperative launch failed: %s (grid %d)\n", hipGetErrorString(e), grid_blocks);
}
```

```cpp
#include <hip/hip_runtime.h>
#include <hip/hip_cooperative_groups.h>
#include <cstdio>
namespace cg = cooperative_groups;
__device__ __forceinline__ int opaque_tid() { int t = (int)threadIdx.x; asm volatile("" : "+v"(t)); return t; }
namespace pg8 {
#define PG8_LAS __attribute__((address_space(3)))
typedef unsigned short bf16_t;
typedef short bf16x8 __attribute__((ext_vector_type(8)));
typedef float f32x4 __attribute__((ext_vector_type(4)));
typedef unsigned u32x4 __attribute__((ext_vector_type(4)));
constexpr int BM = 256, BK = 64, HALF = 128, HTB = HALF * BK * 2  , STAGE_BYTES = 8 * HTB, NXCD = 8, WGM = 8;

__host__ __device__ __forceinline__ int lds_byte(int r, int c) { const int st = (r >> 4) * 2 + (c >> 5), rr = r & 15, cc = c & 31, ob = rr * 64 + cc * 2; return st * 1024 + (ob ^ (((ob >> 9) & 1) << 5)); }
__host__ __device__ __forceinline__ void stage_rc(int b, int& R, int& C) { const int st = b / 1024, sb = b % 1024, swz = sb ^ (((sb >> 9) & 1) << 5); R = (st >> 1) * 16 + swz / 64; C = (st & 1) * 32 + (swz % 64) / 2; }
__host__ __device__ __forceinline__ int perm32(int rho) { const int n = rho >> 4, i = rho & 15; return 8 * (i >> 2) + 4 * n + (i & 3); }

struct Unit { int pm, pn; };
struct Gemm { const bf16_t* A; const bf16_t* Bt; int M, N, K; };

struct StaticOrder {
    int nM, nN, nwg, G, c;
    __host__ __device__ void init(int M, int N, int G_, int c_) { nM = M / BM; nN = N / BM; nwg = nM * nN; G = G_; c = c_; }
    __host__ __device__ bool next(int i, Unit& u) const {
        const long L = (long)i * G + c; if (L >= nwg) return false;
        int wgid = (int)L; { const int q = nwg / NXCD, r = nwg % NXCD, xcd = wgid % NXCD, off = wgid / NXCD; wgid = (xcd < r ? xcd * (q + 1) : r * (q + 1) + (xcd - r) * q) + off; }
        const int nig = WGM * nN, gid = wgid / nig, fm = gid * WGM, gsz = (nM - fm) < WGM ? (nM - fm) : WGM;
        u.pm = fm + ((wgid % nig) % gsz); u.pn = (wgid % nig) / gsz; return true;
    }
    __device__ __forceinline__ void a_ready(const Unit&) const {}
    __device__ __forceinline__ void done(const Unit&) const {}
};
__device__ __forceinline__ unsigned cvt_pk_bf16(float lo, float hi) { unsigned r; asm volatile("v_cvt_pk_bf16_f32 %0, %1, %2" : "=v"(r) : "v"(lo), "v"(hi)); return r; }
template <class Epi, class Sched, bool STAMP = false>
__device__ __forceinline__ void gemm_phase(PG8_LAS unsigned char* lds, const Gemm g, const Sched& S, const Epi& E, unsigned long long* stamps) {
    const int tid = opaque_tid(), wid = __builtin_amdgcn_readfirstlane(tid >> 6), lane = tid & 63, wr = wid >> 2, wc = wid & 3, fr = lane & 15, fq = lane >> 4;
    const int K = g.K, nt = K / BK;
    int ts_lo = 0, ts_hi = 0, nts = 0; const unsigned long long rt_entry = STAMP ? (unsigned long long)wall_clock64() : 0ull;
#define PG8_STAMP() do { if (STAMP && wid == 0 && nts < 64) { const unsigned long long _c = (unsigned long long)clock64(); \
        ts_lo = (lane == nts) ? (int)(unsigned)_c : ts_lo; ts_hi = (lane == nts) ? (int)(unsigned)(_c >> 32) : ts_hi; ++nts; } } while (0)
    PG8_STAMP();
    unsigned voffA[2], voffB[2];
#pragma unroll
    for (int i = 0; i < 2; ++i) { int R, C; stage_rc(tid * 16 + i * 8192, R, C); const int Rb = Epi::PERM ? ((R & ~31) + perm32(R & 31)) : R;
        voffA[i] = (unsigned)(R * K + C) * 2u; voffB[i] = (unsigned)(Rb * K + C) * 2u; }
    const size_t kstep = (size_t)(BK * 2);
    const size_t hstep = (size_t)HALF * K * 2;
    const size_t tstep = 2 * hstep;
    const unsigned ldsw = (unsigned)wid * 1024u;
    const int aoff = lds_byte(wr * 64 + fr, fq * 8), boff = lds_byte(wc * 32 + fr, fq * 8);
#define PG8_SA(b, h) (((b) * 2 + (h)) * HTB)
#define PG8_SB(b, h) ((4 + (b) * 2 + (h)) * HTB)
#define PG8_STAGE(bufoff, gbase, voff) do { _Pragma("unroll") for (int _i = 0; _i < 2; ++_i) \
        __builtin_amdgcn_global_load_lds((const unsigned*)((const char*)(gbase) + (voff)[_i]), (PG8_LAS unsigned*)(lds + (bufoff) + ldsw + _i * 8192), 16, 0, 0); } while (0)
#define PG8_LDA(dst, b, h) do { _Pragma("unroll") for (int m = 0; m < 4; ++m) _Pragma("unroll") for (int k = 0; k < 2; ++k) dst[m][k] = *(const PG8_LAS bf16x8*)(lds + PG8_SA(b, h) + aoff + m * 2048 + k * 1024); } while (0)
#define PG8_LDB(dst, b, h) do { _Pragma("unroll") for (int n = 0; n < 2; ++n) _Pragma("unroll") for (int k = 0; k < 2; ++k) dst[n][k] = *(const PG8_LAS bf16x8*)(lds + PG8_SB(b, h) + boff + n * 2048 + k * 1024); } while (0)
#define PG8_MMA(ai, bj, At, Bt) do { __builtin_amdgcn_s_setprio(1); _Pragma("unroll") for (int m = 0; m < 4; ++m) _Pragma("unroll") for (int n = 0; n < 2; ++n) _Pragma("unroll") for (int k = 0; k < 2; ++k) \
        acc[ai][bj][m][n] = __builtin_amdgcn_mfma_f32_16x16x32_bf16(Bt[n][k], At[m][k], acc[ai][bj][m][n], 0, 0, 0); __builtin_amdgcn_s_setprio(0); } while (0)
#define PG8_WAIT_V(n) asm volatile("s_waitcnt vmcnt(" #n ")" ::: "memory")
#define PG8_WAIT_L(n) asm volatile("s_waitcnt lgkmcnt(" #n ")" ::: "memory")
#define PG8_BAR __builtin_amdgcn_s_barrier()
#define PG8_SCHED __builtin_amdgcn_sched_barrier(0)
    Unit cur, nxt; int ui = 0;
    if (!S.next(0, cur)) return;
    f32x4 acc[2][2][4][2];
#pragma unroll
    for (int a = 0; a < 2; ++a)
#pragma unroll
        for (int b = 0; b < 2; ++b)
#pragma unroll
            for (int m = 0; m < 4; ++m)
#pragma unroll
                for (int n = 0; n < 2; ++n) acc[a][b][m][n] = (f32x4){0.f, 0.f, 0.f, 0.f};
    bf16x8 At[4][2], B0[2][2], B1[2][2];
    const char* cA = (const char*)g.A + (size_t)cur.pm * tstep; const char* cB = (const char*)g.Bt + (size_t)cur.pn * tstep;
    S.a_ready(cur);
    PG8_STAGE(PG8_SB(0, 0), cB, voffB); PG8_STAGE(PG8_SA(0, 0), cA, voffA); PG8_STAGE(PG8_SB(0, 1), cB + hstep, voffB); PG8_STAGE(PG8_SA(0, 1), cA + hstep, voffA);
    if (wr == 1) PG8_BAR;
    PG8_WAIT_V(4); PG8_BAR;
    PG8_STAGE(PG8_SB(1, 0), cB + kstep, voffB); PG8_STAGE(PG8_SA(1, 0), cA + kstep, voffA); PG8_STAGE(PG8_SB(1, 1), cB + hstep + kstep, voffB);
    PG8_WAIT_V(6); PG8_BAR;
    PG8_STAMP();
    for (;;) {
        const bool has_next = S.next(ui + 1, nxt);
        const char* nA = has_next ? (const char*)g.A + (size_t)nxt.pm * tstep : cA; const char* nB = has_next ? (const char*)g.Bt + (size_t)nxt.pn * tstep : cB;
        for (int t = 0; t < nt; t += 2) {
            const bool last = (t == nt - 2);
            const char* a1 = cA + (size_t)(t + 1) * kstep;
            const char* a2 = last ? nA : cA + (size_t)(t + 2) * kstep; const char* b2 = last ? nB : cB + (size_t)(t + 2) * kstep;
            const char* a3 = a2 + kstep; const char* b3 = b2 + kstep;
            if (last && has_next) S.a_ready(nxt);
            PG8_LDB(B0, 0, 0); PG8_SCHED; PG8_LDA(At, 0, 0); PG8_STAGE(PG8_SA(1, 1), a1 + hstep, voffA);
            PG8_WAIT_L(8); PG8_BAR; PG8_WAIT_L(0); PG8_MMA(0, 0, At, B0); PG8_BAR; PG8_SCHED;
            PG8_LDB(B1, 0, 1); PG8_STAGE(PG8_SB(0, 0), b2, voffB);
            PG8_BAR; PG8_WAIT_L(0); PG8_MMA(0, 1, At, B1); PG8_BAR;
            PG8_LDA(At, 0, 1); PG8_STAGE(PG8_SA(0, 0), a2, voffA);
            PG8_BAR; PG8_WAIT_L(0); PG8_MMA(1, 0, At, B0); PG8_BAR; PG8_SCHED;
            PG8_STAGE(PG8_SB(0, 1), b2 + hstep, voffB);
            PG8_WAIT_V(6); PG8_BAR; PG8_MMA(1, 1, At, B1); PG8_BAR;
            PG8_LDB(B0, 1, 0); PG8_SCHED; PG8_LDA(At, 1, 0); PG8_STAGE(PG8_SA(0, 1), a2 + hstep, voffA);
            PG8_WAIT_L(8); PG8_BAR; PG8_WAIT_L(0); PG8_MMA(0, 0, At, B0); PG8_BAR; PG8_SCHED;
            PG8_LDB(B1, 1, 1); PG8_STAGE(PG8_SB(1, 0), b3, voffB);
            PG8_BAR; PG8_WAIT_L(0); PG8_MMA(0, 1, At, B1); PG8_BAR;
            PG8_LDA(At, 1, 1); PG8_STAGE(PG8_SA(1, 0), a3, voffA);
            PG8_BAR; PG8_WAIT_L(0); PG8_MMA(1, 0, At, B0); PG8_BAR; PG8_SCHED;
            PG8_STAGE(PG8_SB(1, 1), b3 + hstep, voffB);
            PG8_WAIT_V(6); PG8_BAR; PG8_MMA(1, 1, At, B1); PG8_BAR;
        }
        PG8_STAMP();
        if constexpr (!Epi::AFTER_DRAIN) { E(acc, cur, wr, wc, fr, fq); S.done(cur); }
        PG8_STAMP();
        if (!has_next) break;
#pragma unroll
        for (int a = 0; a < 2; ++a)
#pragma unroll
            for (int b = 0; b < 2; ++b)
#pragma unroll
                for (int m = 0; m < 4; ++m)
#pragma unroll
                    for (int n = 0; n < 2; ++n) acc[a][b][m][n] = (f32x4){0.f, 0.f, 0.f, 0.f};
        cur = nxt; cA = nA; cB = nB; ++ui;
    }
    PG8_WAIT_V(0);
    if (wr == 0) PG8_BAR;
    PG8_BAR;
    if constexpr (Epi::AFTER_DRAIN) { E.fused(acc, cur, wr, wc, fr, fq, lds, wid, lane); S.done(cur); }
    PG8_STAMP();
    if (STAMP && wid == 0) { stamps[lane] = lane < nts ? (((unsigned long long)(unsigned)ts_hi << 32) | (unsigned)ts_lo) : 0ull;
        if (lane == 62) stamps[62] = rt_entry; if (lane == 63) stamps[63] = (unsigned long long)wall_clock64(); }
#undef PG8_STAMP
#undef PG8_SA
#undef PG8_SB
#undef PG8_STAGE
#undef PG8_LDA
#undef PG8_LDB
#undef PG8_MMA
#undef PG8_WAIT_V
#undef PG8_WAIT_L
#undef PG8_BAR
#undef PG8_SCHED
}
}

#define LAS __attribute__((address_space(3)))
#define XB_TMO      128
#define XB_XCNT(j)  (256  + 64 * (j))
#define XB_XSUB(j)  (1280 + 64 * (j))
#define XB_XGEN(j)  (2304 + 64 * (j))
#define XB_TOP      3328
#define XB_TOPGEN   3392
#define XCD_BAR_WORDS 3456
#define XB_SPIN_CAP (1u << 18)

__device__ __forceinline__ unsigned xb_ld(unsigned* p)              { return __hip_atomic_load(p, __ATOMIC_RELAXED, __HIP_MEMORY_SCOPE_AGENT); }
__device__ __forceinline__ unsigned xb_add(unsigned* p, unsigned v) { return __hip_atomic_fetch_add(p, v, __ATOMIC_RELAXED, __HIP_MEMORY_SCOPE_AGENT); }
__device__ __forceinline__ unsigned xb_xcc_id() { return (unsigned)__builtin_amdgcn_s_getreg((3 << 11) | 20) & 0xFu; }
#define XB_SPIN(cond, bar) do { unsigned _sp = 0; while (cond) { __builtin_amdgcn_s_sleep(1); \
    if ((++_sp & 255u) == 0u) { if (xb_ld(&(bar)[XB_TMO])) break; if (_sp > XB_SPIN_CAP) { atomicAdd(&(bar)[XB_TMO], 1u); break; } } } } while (0)

struct XcdBarrier {
    unsigned* bar; unsigned x;
    volatile LAS unsigned* st;
};

__device__ __forceinline__ XcdBarrier xcd_barrier_post(unsigned* bar, volatile LAS unsigned* st) {
    XcdBarrier b; b.bar = bar; b.x = xb_xcc_id(); b.st = st;
    if (threadIdx.x == 0) (void)xb_add(&bar[XB_XCNT(b.x)], 1u);
    return b;
}
__device__ __forceinline__ void xcd_barrier_complete(unsigned* bar, unsigned x, unsigned& nloc, unsigned& nx) {
    const unsigned G = gridDim.x * gridDim.y * gridDim.z;
    unsigned sum, cnt, mine, sp = 0u;
    for (;;) {
        sum = 0u; cnt = 0u; mine = 0u;
#pragma unroll
        for (unsigned j = 0; j < 16; ++j) { const unsigned c = xb_ld(&bar[XB_XCNT(j)]); sum += c; cnt += (c > 0u) ? 1u : 0u; mine = (j == x) ? c : mine; }
        if (sum == G) break;
        __builtin_amdgcn_s_sleep(1);
        if ((++sp & 255u) == 0u) { if (xb_ld(&bar[XB_TMO])) break; if (sp > XB_SPIN_CAP) { atomicAdd(&bar[XB_TMO], 1u); break; } }
    }
    nloc = mine > 0u ? mine : 1u; nx = cnt > 0u ? cnt : 1u;
}

__device__ __forceinline__ void xcd_barrier(const XcdBarrier& b) {
    asm volatile("s_waitcnt vmcnt(0)" ::: "memory");
    __syncthreads();
    if (threadIdx.x == 0) {
        unsigned* bar = b.bar;
        __builtin_amdgcn_s_waitcnt(0);
        unsigned nloc = b.st[0], nx = b.st[1];
        if (nloc == 0u) { xcd_barrier_complete(bar, b.x, nloc, nx); b.st[0] = nloc; b.st[1] = nx; }
        const unsigned old = xb_add(&bar[XB_XSUB(b.x)], 1u);
        const unsigned gen = old / nloc;
        if (old + 1u == (gen + 1u) * nloc) {
            __builtin_amdgcn_fence(__ATOMIC_RELEASE, "agent");
            asm volatile("s_waitcnt vmcnt(0)" ::: "memory");
            const unsigned og = xb_add(&bar[XB_TOP], 1u);
            const unsigned tg = og / nx;
            if (og + 1u == (tg + 1u) * nx) xb_add(&bar[XB_TOPGEN], 1u);
            else XB_SPIN(xb_ld(&bar[XB_TOPGEN]) == tg, bar);
            __builtin_amdgcn_fence(__ATOMIC_ACQUIRE, "agent");
            xb_add(&bar[XB_XGEN(b.x)], 1u);
            asm volatile("s_waitcnt vmcnt(0)" ::: "memory");
        } else {
            XB_SPIN(xb_ld(&bar[XB_XGEN(b.x)]) == gen, bar);
            __builtin_amdgcn_fence(__ATOMIC_ACQUIRE, "agent");
            asm volatile("s_waitcnt vmcnt(0)" ::: "memory");
        }
    }
    __syncthreads();
}
using namespace pg8;

typedef unsigned u32x2 __attribute__((ext_vector_type(2)));
typedef float f32x2v __attribute__((ext_vector_type(2)));

constexpr int DM = 2048, SEQ = 4096, NTOK_P = 8192, NTOK = 8224, M_PAD = 8448, NIN = 5632, DFF = 5632, PLE = 256;
constexpr int ZC_AQ = 0, ZC_AK = 1024, ZC_AV = 1280, ZC_RQ = 1536, ZC_RK = 2560, ZC_RV = 3584, ZC_RG = 4608;
constexpr float EPS = 1e-6f;
constexpr float ATTN_SCALE = 0.08838834764831845f, RET_K_SCALE = 0.08838834764831845f;
constexpr size_t O_YP = 0, O_YS = 16777216, O_KWP = 16842752, O_VWP = 16908288, O_RSP = 16973824, O_KWS = 17235968, O_VWS = 18284544, O_RSS = 19333120;
constexpr size_t W_IN = 0;
constexpr size_t W_OUT = W_IN + (size_t)NIN * DM * 2;
constexpr size_t W_GU = W_OUT + (size_t)DM * DM * 2;
constexpr size_t W_DOWN = W_GU + (size_t)2 * DFF * DM * 2;
constexpr size_t W_PLE = W_DOWN + (size_t)DM * DFF * 2;
constexpr size_t W_PG = W_PLE + (size_t)DM * PLE * 2;
constexpr size_t BUF_A = W_PG + (size_t)DM * DM * 2;
constexpr size_t BUF_B = BUF_A + (size_t)M_PAD * DM * 2;
constexpr size_t BUF_Z = BUF_B + (size_t)M_PAD * DM * 2;
constexpr size_t BUF_P = BUF_Z + (size_t)M_PAD * NIN * 2;
constexpr size_t BUF_RS = BUF_P + (size_t)M_PAD * PLE * 2;
constexpr size_t BUF_ROPE = BUF_RS + (size_t)2 * M_PAD * 4;
constexpr size_t BUF_BAR = ((BUF_ROPE + (size_t)2 * 4097 * 64 * 4 + 255) / 256) * 256;
constexpr size_t BUF_MIX = ((BUF_BAR + (size_t)XCD_BAR_WORDS * 4 + 255) / 256) * 256;
constexpr size_t BUF_XS = BUF_MIX + (size_t)M_PAD * DM * 2;
constexpr size_t WS_END = BUF_XS + (size_t)M_PAD * 4;
constexpr size_t BUF_KV16 = BUF_B;
constexpr size_t BUF_S16 = BUF_B + (size_t)512 * 16384 * 2;
constexpr int LDS_PHASE_BYTES = 141312, LDS_BYTES = LDS_PHASE_BYTES + 16;

struct Params {
  const float *x_p, *x_s, *ck, *cv, *st, *p_p, *p_s, *an, *w_in, *qn, *kn, *sinks, *rg, *w_out, *fn, *w_gate, *w_up, *w_down, *pn, *w_ple, *w_pg;
  float* out; unsigned char* ws; int never; int pad0;
};

__device__ __forceinline__ float bf_lo(unsigned w) { return __uint_as_float(w << 16); }
__device__ __forceinline__ float bf_hi(unsigned w) { return __uint_as_float(w & 0xffff0000u); }
__device__ __forceinline__ float bf2f(bf16_t v) { return __uint_as_float(((unsigned)v) << 16); }
__device__ __forceinline__ void unpack8(const u32x4 w, float (&f)[8]) {
  f[0] = bf_lo(w.x); f[1] = bf_hi(w.x); f[2] = bf_lo(w.y); f[3] = bf_hi(w.y); f[4] = bf_lo(w.z); f[5] = bf_hi(w.z); f[6] = bf_lo(w.w); f[7] = bf_hi(w.w);
}
__device__ __forceinline__ u32x4 pack8(const float (&f)[8]) {
  u32x4 w; w.x = cvt_pk_bf16(f[0], f[1]); w.y = cvt_pk_bf16(f[2], f[3]); w.z = cvt_pk_bf16(f[4], f[5]); w.w = cvt_pk_bf16(f[6], f[7]); return w;
}
__device__ __forceinline__ unsigned half_of(const u32x4 w, int e) { const unsigned x = (e >> 1) == 0 ? w.x : (e >> 1) == 1 ? w.y : (e >> 1) == 2 ? w.z : w.w; return (e & 1) ? (x >> 16) : (x & 0xffffu); }
__device__ __forceinline__ float sigmoid_f(float x) { return __builtin_amdgcn_rcpf(1.0f + __builtin_amdgcn_exp2f(x * -1.4426950408889634f)); }
__device__ __forceinline__ float silu_f(float x) { return x * sigmoid_f(x); }
__device__ __forceinline__ float wave_sum(float v) { for (int o = 32; o >= 1; o >>= 1) v += __shfl_xor(v, o); return v; }
__device__ __forceinline__ float wave_max(float v) { for (int o = 32; o >= 1; o >>= 1) v = fmaxf(v, __shfl_xor(v, o)); return v; }
__device__ __forceinline__ float ret_lg(int h) { return log1pf(-exp2f(-5.0f - (float)h)); }

struct EpiZ {
  static constexpr bool PERM = true, AFTER_DRAIN = false;
  bf16_t* O; int ldc;
  __device__ __forceinline__ void operator()(const f32x4 (&acc)[2][2][4][2], const Unit& u, int wr, int wc, int fr, int fq) const {
    const int row0 = u.pm * BM + wr * 64 + fr, col0 = u.pn * BM + wc * 32 + 8 * fq;
#pragma unroll
    for (int ai = 0; ai < 2; ++ai)
#pragma unroll
      for (int m = 0; m < 4; ++m) { bf16_t* rowp = O + (size_t)(row0 + ai * HALF + m * 16) * ldc + col0;
#pragma unroll
        for (int bj = 0; bj < 2; ++bj) { const f32x4 v0 = acc[ai][bj][m][0], v1 = acc[ai][bj][m][1];
          u32x4 w; w.x = cvt_pk_bf16(v0[0], v0[1]); w.y = cvt_pk_bf16(v0[2], v0[3]); w.z = cvt_pk_bf16(v1[0], v1[1]); w.w = cvt_pk_bf16(v1[2], v1[3]);
          *(u32x4*)(rowp + bj * HALF) = w; } }
  }
};
struct EpiRes3 {
  static constexpr bool PERM = true, AFTER_DRAIN = false;
  const bf16_t* A0; const float* xs; const float* an; bf16_t* HG; const float* g; float* rs;
  __device__ __forceinline__ void operator()(const f32x4 (&acc)[2][2][4][2], const Unit& u, int wr, int wc, int fr, int fq) const {
    const int row0 = u.pm * BM + wr * 64 + fr, col0 = u.pn * BM + wc * 32 + 8 * fq;
    float gi[2][8];
#pragma unroll
    for (int bj = 0; bj < 2; ++bj)
#pragma unroll
      for (int hf = 0; hf < 2; ++hf) { const f32x4 a = *(const f32x4*)(an + col0 + bj * HALF + hf * 4);
#pragma unroll
        for (int j = 0; j < 4; ++j) gi[bj][hf * 4 + j] = __builtin_amdgcn_rcpf(a[j]); }
#pragma unroll
    for (int ai = 0; ai < 2; ++ai) {
#pragma unroll
     for (int mb = 0; mb < 4; mb += 2) {
      u32x4 rr[4][2]; float xr[4];
#pragma unroll
      for (int m = mb; m < mb + 2; ++m) { xr[m] = xs[row0 + ai * HALF + m * 16];
#pragma unroll
        for (int bj = 0; bj < 2; ++bj) rr[m][bj] = *(const u32x4*)(A0 + (size_t)(row0 + ai * HALF + m * 16) * DM + col0 + bj * HALF); }
#pragma unroll
      for (int m = mb; m < mb + 2; ++m) {
        const int row = row0 + ai * HALF + m * 16; bf16_t* hp = HG + (size_t)row * DM + col0; float ss = 0.f;
#pragma unroll
        for (int bj = 0; bj < 2; ++bj) {
          float h[8]; unpack8(rr[m][bj], h);
#pragma unroll
          for (int j = 0; j < 8; ++j) { h[j] = h[j] * xr[m] * gi[bj][j] + acc[ai][bj][m][j >> 2][j & 3]; ss += h[j] * h[j]; }
          { const f32x4 o0 = *(const f32x4*)(g + col0 + bj * HALF), o1 = *(const f32x4*)(g + col0 + bj * HALF + 4);
#pragma unroll
            for (int j = 0; j < 8; ++j) h[j] *= (j < 4 ? o0[j & 3] : o1[j & 3]); }
          *(u32x4*)(hp + bj * HALF) = pack8(h); }
        ss += __shfl_xor(ss, 16); ss += __shfl_xor(ss, 32);
        if (fq == 0) atomicAdd(rs + row, ss);
      }
     }
    }
  }
};
struct EpiRes5 {
  static constexpr bool PERM = true, AFTER_DRAIN = false;
  const bf16_t* HGin; const float* gin; bf16_t* HGout; const float* gout; float* rs;
  __device__ __forceinline__ void operator()(const f32x4 (&acc)[2][2][4][2], const Unit& u, int wr, int wc, int fr, int fq) const {
    const int row0 = u.pm * BM + wr * 64 + fr, col0 = u.pn * BM + wc * 32 + 8 * fq;
    float gi[2][8];
#pragma unroll
    for (int bj = 0; bj < 2; ++bj)
#pragma unroll
      for (int hf = 0; hf < 2; ++hf) { const f32x4 a = *(const f32x4*)(gin + col0 + bj * HALF + hf * 4);
#pragma unroll
        for (int j = 0; j < 4; ++j) gi[bj][hf * 4 + j] = __builtin_amdgcn_rcpf(a[j]); }
#pragma unroll
    for (int ai = 0; ai < 2; ++ai) {
#pragma unroll
     for (int mb = 0; mb < 4; mb += 2) {
      u32x4 rr[4][2];
#pragma unroll
      for (int m = mb; m < mb + 2; ++m)
#pragma unroll
        for (int bj = 0; bj < 2; ++bj) rr[m][bj] = *(const u32x4*)(HGin + (size_t)(row0 + ai * HALF + m * 16) * DM + col0 + bj * HALF);
#pragma unroll
      for (int m = mb; m < mb + 2; ++m) {
        const int row = row0 + ai * HALF + m * 16; bf16_t* hp = HGout + (size_t)row * DM + col0; float ss = 0.f;
#pragma unroll
        for (int bj = 0; bj < 2; ++bj) {
          float h[8]; unpack8(rr[m][bj], h);
#pragma unroll
          for (int j = 0; j < 8; ++j) { h[j] = h[j] * gi[bj][j] + acc[ai][bj][m][j >> 2][j & 3]; ss += h[j] * h[j]; }
          { const f32x4 o0 = *(const f32x4*)(gout + col0 + bj * HALF), o1 = *(const f32x4*)(gout + col0 + bj * HALF + 4);
#pragma unroll
            for (int j = 0; j < 8; ++j) h[j] *= (j < 4 ? o0[j & 3] : o1[j & 3]); }
          *(u32x4*)(hp + bj * HALF) = pack8(h); }
        ss += __shfl_xor(ss, 16); ss += __shfl_xor(ss, 32);
        if (fq == 0) atomicAdd(rs + row, ss);
      }
     }
    }
  }
};
struct EpiAct {
  static constexpr bool PERM = true, AFTER_DRAIN = false;
  bf16_t* O; const float* rs;
  __device__ __forceinline__ void operator()(const f32x4 (&acc)[2][2][4][2], const Unit& u, int wr, int wc, int fr, int fq) const {
    const int row0 = u.pm * BM + wr * 64 + fr, col0 = u.pn * HALF + wc * 32 + 8 * fq;
#pragma unroll
    for (int ai = 0; ai < 2; ++ai)
#pragma unroll
      for (int m = 0; m < 4; ++m) {
        const int row = row0 + ai * HALF + m * 16;
        const float r = rsqrtf(rs[row] * (1.0f / DM) + EPS);
        float a[8];
#pragma unroll
        for (int n = 0; n < 2; ++n)
#pragma unroll
          for (int j = 0; j < 4; ++j) { const float gg = acc[ai][0][m][n][j] * r, uu = acc[ai][1][m][n][j] * r; a[n * 4 + j] = silu_f(gg) * uu; }
        *(u32x4*)(O + (size_t)row * DFF + col0) = pack8(a);
      }
  }
};
struct EpiPle {
  static constexpr bool PERM = true, AFTER_DRAIN = false;
  float* out; const bf16_t* HG; const float* g; const bf16_t* T; const float* rs;
  __device__ __forceinline__ void operator()(const f32x4 (&acc)[2][2][4][2], const Unit& u, int wr, int wc, int fr, int fq) const {
    const int row0 = u.pm * BM + wr * 64 + fr, col0 = u.pn * BM + wc * 32 + 8 * fq;
    float gi[2][8];
#pragma unroll
    for (int bj = 0; bj < 2; ++bj)
#pragma unroll
      for (int hf = 0; hf < 2; ++hf) { const f32x4 a = *(const f32x4*)(g + col0 + bj * HALF + hf * 4);
#pragma unroll
        for (int j = 0; j < 4; ++j) gi[bj][hf * 4 + j] = __builtin_amdgcn_rcpf(a[j]); }
#pragma unroll
    for (int ai = 0; ai < 2; ++ai) {
#pragma unroll
     for (int mb = 0; mb < 4; mb += 2) {
      u32x4 rh[4][2], rt[4][2]; float rr[4];
#pragma unroll
      for (int m = mb; m < mb + 2; ++m) { const int row = row0 + ai * HALF + m * 16; rr[m] = rs[row];
#pragma unroll
        for (int bj = 0; bj < 2; ++bj) { rh[m][bj] = *(const u32x4*)(HG + (size_t)row * DM + col0 + bj * HALF); rt[m][bj] = *(const u32x4*)(T + (size_t)row * DM + col0 + bj * HALF); } }
#pragma unroll
      for (int m = mb; m < mb + 2; ++m) {
        const int row = row0 + ai * HALF + m * 16; const float r = rsqrtf(rr[m] * (1.0f / DM) + EPS); float* op = out + (size_t)row * DM + col0;
#pragma unroll
        for (int bj = 0; bj < 2; ++bj) {
          float h[8], t[8]; unpack8(rh[m][bj], h); unpack8(rt[m][bj], t);
#pragma unroll
          for (int j = 0; j < 8; ++j) h[j] = h[j] * gi[bj][j] + t[j] * sigmoid_f(acc[ai][bj][m][j >> 2][j & 3] * r);
          *(f32x4*)(op + bj * HALF) = (f32x4){h[0], h[1], h[2], h[3]}; *(f32x4*)(op + bj * HALF + 4) = (f32x4){h[4], h[5], h[6], h[7]}; }
      }
     }
    }
  }
};
struct TDesc { const float* src; bf16_t* dst; int K, N, rs, off, t; };
constexpr int TT_IN = (DM / 128) * (NIN / 64), TT_OUT = (DM / 128) * (DM / 64), TT_G = (DM / 128) * (DFF / 64), TT_D = (DFF / 128) * (DM / 64), TT_PL = (PLE / 128) * (DM / 64), TT_PG = TT_OUT;
template <int LIST> __device__ __forceinline__ int tjobs() { return LIST == 0 ? TT_IN + 2 * TT_G + TT_OUT + TT_PG + TT_PL : LIST == 1 ? 0 : TT_D; }
template <int LIST> __device__ __forceinline__ TDesc tdesc(const Params& p, int g) {
  unsigned char* ws = p.ws; TDesc d;
  if (LIST == 0) {
    if (g < TT_IN) d = TDesc{p.w_in, (bf16_t*)(ws + W_IN), DM, NIN, 128, 0, g};
    else if (g < TT_IN + TT_G) d = TDesc{p.w_gate, (bf16_t*)(ws + W_GU), DM, DFF, 256, 0, g - TT_IN};
    else if (g < TT_IN + 2 * TT_G) d = TDesc{p.w_up, (bf16_t*)(ws + W_GU), DM, DFF, 256, 128, g - TT_IN - TT_G};
    else if (g < TT_IN + 2 * TT_G + TT_OUT) d = TDesc{p.w_out, (bf16_t*)(ws + W_OUT), DM, DM, 128, 0, g - TT_IN - 2 * TT_G};
    else if (g < TT_IN + 2 * TT_G + TT_OUT + TT_PG) d = TDesc{p.w_pg, (bf16_t*)(ws + W_PG), DM, DM, 128, 0, g - TT_IN - 2 * TT_G - TT_OUT};
    else d = TDesc{p.w_ple, (bf16_t*)(ws + W_PLE), PLE, DM, 128, 0, g - TT_IN - 2 * TT_G - TT_OUT - TT_PG};
  } else if (LIST == 1) d = TDesc{p.w_out, (bf16_t*)(ws + W_OUT), DM, DM, 128, 0, g};
  else {
    d = TDesc{p.w_down, (bf16_t*)(ws + W_DOWN), DFF, DM, 128, 0, g};
  }
  return d;
}
template <int LIST> __device__ __forceinline__ void tload4(const Params& p, int g0, int step, f32x4 (&v)[4][4]) {
  const int tid = opaque_tid(), njobs = tjobs<LIST>();
#pragma unroll
  for (int u = 0; u < 4; ++u) { const int g = g0 + u * step;
    if (g < njobs) { const TDesc d = tdesc<LIST>(p, g); const int nnt = d.N >> 7, k0 = (d.t / nnt) * 64, n0 = (d.t % nnt) * 128;
#pragma unroll
      for (int i = 0; i < 4; ++i) v[u][i] = __builtin_nontemporal_load((const f32x4*)(d.src + (size_t)(k0 + (tid >> 5) + 16 * i) * d.N + n0 + (tid & 31) * 4)); } }
}
template <int LIST> __device__ __forceinline__ void transpose_jobs(const Params& p, LAS unsigned char* lds, int first, int step) {
  const int tid = opaque_tid(), njobs = tjobs<LIST>();
  if (first >= njobs) return;
  f32x4 v[4][4], vn[4][4];
  tload4<LIST>(p, first, step, v);
  for (int g0 = first; g0 < njobs; g0 += 4 * step) {
    const bool more = g0 + 4 * step < njobs;
    if (more) tload4<LIST>(p, g0 + 4 * step, step, vn);
#pragma unroll
    for (int u = 0; u < 4; ++u) { if (g0 + u * step < njobs) { LAS float* tile = (LAS float*)lds + u * (64 * 129);
#pragma unroll
        for (int i = 0; i < 4; ++i) { LAS float* q = tile + ((tid >> 5) + 16 * i) * 129 + (tid & 31) * 4; q[0] = v[u][i][0]; q[1] = v[u][i][1]; q[2] = v[u][i][2]; q[3] = v[u][i][3]; } } }
    __syncthreads();
#pragma unroll
    for (int u = 0; u < 4; ++u) { const int g = g0 + u * step;
      if (g < njobs) { const TDesc d = tdesc<LIST>(p, g); const int nnt = d.N >> 7, k0 = (d.t / nnt) * 64, n0 = (d.t % nnt) * 128;
        const LAS float* tile = (const LAS float*)lds + u * (64 * 129);
        const int n = tid >> 2, kb = (tid & 3) * 16; float f[16];
#pragma unroll
        for (int j = 0; j < 16; ++j) f[j] = tile[(kb + j) * 129 + n];
        const int nn = n0 + n, drow = (nn >> 7) * d.rs + (nn & 127) + d.off;
        bf16_t* dp = d.dst + (size_t)drow * d.K + k0 + kb;
        u32x4 w0, w1;
        w0.x = cvt_pk_bf16(f[0], f[1]); w0.y = cvt_pk_bf16(f[2], f[3]); w0.z = cvt_pk_bf16(f[4], f[5]); w0.w = cvt_pk_bf16(f[6], f[7]);
        w1.x = cvt_pk_bf16(f[8], f[9]); w1.y = cvt_pk_bf16(f[10], f[11]); w1.z = cvt_pk_bf16(f[12], f[13]); w1.w = cvt_pk_bf16(f[14], f[15]);
        *(u32x4*)dp = w0; *(u32x4*)(dp + 8) = w1; } }
    __syncthreads();
    if (more) {
#pragma unroll
      for (int u = 0; u < 4; ++u)
#pragma unroll
        for (int i = 0; i < 4; ++i) v[u][i] = vn[u][i]; }
  }
}

__device__ __forceinline__ void phase_prep(const Params& p, LAS unsigned char* lds) {
  const int tid = opaque_tid(), wid = __builtin_amdgcn_readfirstlane(tid >> 6), lane = tid & 63;
  unsigned char* ws = p.ws;
  transpose_jobs<0>(p, lds, blockIdx.x, gridDim.x);
  {
    bf16_t* A0 = (bf16_t*)(ws + BUF_A);
    for (int row = blockIdx.x * 8 + wid; row < M_PAD; row += gridDim.x * 8) {
      bf16_t* dst = A0 + (size_t)row * DM;
      if (row >= NTOK) {
#pragma unroll
        for (int i = 0; i < 8; ++i) *(u32x2*)(dst + (i * 64 + lane) * 4) = (u32x2){0u, 0u};
        continue;
      }
      const float* src = row < NTOK_P ? p.x_p + (size_t)row * DM : p.x_s + (size_t)(row - NTOK_P) * DM;
      f32x4 v[8]; float ss = 0.f;
#pragma unroll
      for (int i = 0; i < 8; ++i) { v[i] = __builtin_nontemporal_load((const f32x4*)(src + (i * 64 + lane) * 4)); ss += v[i][0] * v[i][0] + v[i][1] * v[i][1] + v[i][2] * v[i][2] + v[i][3] * v[i][3]; }
      ss = wave_sum(ss);
      const float r = rsqrtf(ss * (1.0f / DM) + EPS);
      if (lane == 0) ((float*)(ws + BUF_XS))[row] = sqrtf(ss * (1.0f / DM) + EPS);
#pragma unroll
      for (int i = 0; i < 8; ++i) { const f32x4 g = *(const f32x4*)(p.an + (i * 64 + lane) * 4); const f32x4 y = v[i] * r * g;
        *(u32x2*)(dst + (i * 64 + lane) * 4) = (u32x2){cvt_pk_bf16(y[0], y[1]), cvt_pk_bf16(y[2], y[3])}; }
    }
  }
  const size_t gtid = (size_t)blockIdx.x * 512 + tid, gstride = (size_t)gridDim.x * 512;
  {
    bf16_t* P = (bf16_t*)(ws + BUF_P);
    for (size_t i = gtid; i < (size_t)M_PAD * 64; i += gstride) {
      const int row = (int)(i >> 6), c4 = (int)(i & 63) * 4;
      f32x4 v = (f32x4){0.f, 0.f, 0.f, 0.f};
      if (row < NTOK_P) v = *(const f32x4*)(p.p_p + (size_t)row * PLE + c4); else if (row < NTOK) v = *(const f32x4*)(p.p_s + (size_t)(row - NTOK_P) * PLE + c4);
      *(u32x2*)(P + (size_t)row * PLE + c4) = (u32x2){cvt_pk_bf16(v[0], v[1]), cvt_pk_bf16(v[2], v[3])};
    }
  }
  { float* rs = (float*)(ws + BUF_RS); for (size_t i = gtid; i < (size_t)2 * M_PAD; i += gstride) rs[i] = 0.f; }
  {
    float* rc = (float*)(ws + BUF_ROPE); float* rsn = rc + 4097 * 64;
    for (size_t i = gtid; i < (size_t)4097 * 64; i += gstride) {
      const int e = (int)(i >> 6), j = (int)(i & 63);
      const float pos = e < 4096 ? (float)e : 16384.0f;
      const float inv = (float)exp2(-(double)j * (13.287712379549449 / 64.0));
      const float ang = pos * inv;
      const double rev = (double)ang * 0.15915494309189535; const float fr = (float)(rev - floor(rev));
      rc[i] = __builtin_amdgcn_cosf(fr); rsn[i] = __builtin_amdgcn_sinf(fr);
    }
  }
}

#define MFMA16(a, b, c) __builtin_amdgcn_mfma_f32_16x16x32_bf16((a), (b), (c), 0, 0, 0)
constexpr int LDR = 272;
__device__ __forceinline__ void wave_store_rows16(const LAS unsigned char* buf, int rs, bf16_t* g, size_t grs, int lane) {
#pragma unroll
  for (int i = 0; i < 4; ++i) { const int row = (lane >> 4) + 4 * i, ch = lane & 15; *(u32x4*)(g + (size_t)row * grs + ch * 8) = *(const LAS u32x4*)(buf + row * rs + ch * 16); }
}

__device__ __forceinline__ void rot16(const bf16_t* zrow, int cc, const float* rc, const float* rsn, int pos_entry, float sc, float (&o1)[8], float (&o2)[8]) {
  float x1[8], x2[8]; unpack8(*(const u32x4*)(zrow + cc * 8), x1); unpack8(*(const u32x4*)(zrow + 64 + cc * 8), x2);
  const f32x4 c0 = *(const f32x4*)(rc + pos_entry * 64 + cc * 8), c1 = *(const f32x4*)(rc + pos_entry * 64 + cc * 8 + 4);
  const f32x4 s0 = *(const f32x4*)(rsn + pos_entry * 64 + cc * 8), s1 = *(const f32x4*)(rsn + pos_entry * 64 + cc * 8 + 4);
#pragma unroll
  for (int e = 0; e < 8; ++e) { const float cs = e < 4 ? c0[e & 3] : c1[e & 3], sn = e < 4 ? s0[e & 3] : s1[e & 3];
    o1[e] = (x1[e] * cs - x2[e] * sn) * sc; o2[e] = (x1[e] * sn + x2[e] * cs) * sc; }
}

__device__ __forceinline__ void attn_item(const Params& p, LAS unsigned char* lds, int item) {
  constexpr int K_OFF = 0, V_OFF = 256 * LDR, VLD = 560, PLD = 336, PWAVE = 16 * PLD;
  const int tid = opaque_tid(), wid = __builtin_amdgcn_readfirstlane(tid >> 6), lane = tid & 63, fr = lane & 15, fq = lane >> 4;
  int b, blk, h;
  if (gridDim.x == 256) { const int r = item >> 8, cidx = item & 255, x = cidx & 7, y = cidx >> 3, s = r * 8 + x;
    b = s & 1; h = ((s >> 1) & 1) * 4 + (y & 3); blk = (s >> 2) * 8 + (y >> 2); }
  else { b = item >> 8; blk = (item >> 3) & 31; h = item & 7; }
  const int kvh = h >> 2;
  const bf16_t* Z = (const bf16_t*)(p.ws + BUF_Z);
  bf16_t* MIX = (bf16_t*)(p.ws + BUF_MIX);
  const int tok0 = b * SEQ + blk * 128;
  bf16x8 Qa[4];
  {
    const bf16_t* qp = Z + (size_t)(tok0 + wid * 16 + fr) * NIN + ZC_AQ + h * 128 + fq * 8;
    float qf[4][8]; float ss = 0.f;
#pragma unroll
    for (int ks = 0; ks < 4; ++ks) { unpack8(*(const u32x4*)(qp + ks * 32), qf[ks]);
#pragma unroll
      for (int e = 0; e < 8; ++e) ss += qf[ks][e] * qf[ks][e]; }
    ss += __shfl_xor(ss, 16); ss += __shfl_xor(ss, 32);
    const float r = rsqrtf(ss * (1.0f / 128.0f) + EPS);
#pragma unroll
    for (int ks = 0; ks < 4; ++ks) { const f32x4 g0 = *(const f32x4*)(p.qn + ks * 32 + fq * 8), g1 = *(const f32x4*)(p.qn + ks * 32 + fq * 8 + 4);
      float y[8];
#pragma unroll
      for (int e = 0; e < 8; ++e) y[e] = qf[ks][e] * r * (e < 4 ? g0[e & 3] : g1[e & 3]);
      const u32x4 w = pack8(y); Qa[ks] = *(const bf16x8*)&w; }
  }
  const bool write_win = (blk == 31) && ((h & 3) == 0);
  {
    const int c = tid & 15; const f32x4 g0 = *(const f32x4*)(p.kn + c * 8), g1 = *(const f32x4*)(p.kn + c * 8 + 4);
#pragma unroll
    for (int i = 0; i < 8; ++i) {
      const int row = (tid >> 4) + 32 * i, kpos = (blk - 1) * 128 + row;
      u32x4 raw = (u32x4){0u, 0u, 0u, 0u};
      if (kpos >= 0) raw = *(const u32x4*)(Z + (size_t)(b * SEQ + kpos) * NIN + ZC_AK + kvh * 128 + c * 8);
      float f[8]; unpack8(raw, f); float ss = 0.f;
#pragma unroll
      for (int e = 0; e < 8; ++e) ss += f[e] * f[e];
      ss += __shfl_xor(ss, 1); ss += __shfl_xor(ss, 2); ss += __shfl_xor(ss, 4); ss += __shfl_xor(ss, 8);
      const float r = rsqrtf(ss * (1.0f / 128.0f) + EPS);
#pragma unroll
      for (int e = 0; e < 8; ++e) f[e] = f[e] * r * (e < 4 ? g0[e & 3] : g1[e & 3]);
      *(LAS u32x4*)(lds + K_OFF + row * LDR + c * 16) = pack8(f);
      if (write_win && row >= 128) { float* kw = p.out + O_KWP + ((size_t)(b * 128 + row - 128) * 2 + kvh) * 128 + c * 8;
        *(f32x4*)kw = (f32x4){f[0], f[1], f[2], f[3]}; *(f32x4*)(kw + 4) = (f32x4){f[4], f[5], f[6], f[7]}; }
    }
  }
  {
    const int c = tid & 15;
#pragma unroll
    for (int i = 0; i < 4; ++i) {
      const int kp = (tid >> 4) + 32 * i, j0 = 2 * kp, kpos = (blk - 1) * 128 + j0;
      u32x4 r0 = (u32x4){0u, 0u, 0u, 0u}, r1 = r0;
      if (kpos >= 0) { const bf16_t* vp = Z + (size_t)(b * SEQ + kpos) * NIN + ZC_AV + kvh * 128 + c * 8; r0 = *(const u32x4*)vp; r1 = *(const u32x4*)(vp + NIN); }
#pragma unroll
      for (int e = 0; e < 8; ++e) *(LAS unsigned*)(lds + V_OFF + (c * 8 + e) * VLD + (kp ^ (c << 2)) * 4) = half_of(r0, e) | (half_of(r1, e) << 16);
      if (write_win && j0 >= 128) { float f0[8], f1[8]; unpack8(r0, f0); unpack8(r1, f1);
        float* vw = p.out + O_VWP + ((size_t)(b * 128 + j0 - 128) * 2 + kvh) * 128 + c * 8;
        *(f32x4*)vw = (f32x4){f0[0], f0[1], f0[2], f0[3]}; *(f32x4*)(vw + 4) = (f32x4){f0[4], f0[5], f0[6], f0[7]};
        *(f32x4*)(vw + 256) = (f32x4){f1[0], f1[1], f1[2], f1[3]}; *(f32x4*)(vw + 260) = (f32x4){f1[4], f1[5], f1[6], f1[7]}; }
    }
    if (tid < 256) *(LAS u32x4*)(lds + V_OFF + (tid >> 1) * VLD + 512 + (tid & 1) * 16) = (u32x4){0u, 0u, 0u, 0u};
  }
  __syncthreads();
  f32x4 S[9];
#pragma unroll
  for (int tt = 0; tt < 9; ++tt) S[tt] = (f32x4){0.f, 0.f, 0.f, 0.f};
#pragma unroll
  for (int ks = 0; ks < 4; ++ks)
#pragma unroll
    for (int tt = 0; tt < 9; ++tt) { const bf16x8 kb = *(const LAS bf16x8*)(lds + K_OFF + ((wid + tt) * 16 + fr) * LDR + (ks * 32 + fq * 8) * 2); S[tt] = MFMA16(kb, Qa[ks], S[tt]); }
  const int qi = wid * 16 + fr; const float sink = p.sinks[h];
  float mx = sink;
#pragma unroll
  for (int tt = 0; tt < 9; ++tt)
#pragma unroll
    for (int jj = 0; jj < 4; ++jj) { const int j = (wid + tt) * 16 + fq * 4 + jj; const bool valid = (j >= qi) && (j <= qi + 128) && (blk > 0 || j >= 128);
      const float s = valid ? S[tt][jj] * ATTN_SCALE : -INFINITY; S[tt][jj] = s; mx = fmaxf(mx, s); }
  mx = fmaxf(mx, __shfl_xor(mx, 16)); mx = fmaxf(mx, __shfl_xor(mx, 32));
  float sum = 0.f;
#pragma unroll
  for (int tt = 0; tt < 9; ++tt)
#pragma unroll
    for (int jj = 0; jj < 4; ++jj) { const float e = __expf(S[tt][jj] - mx); S[tt][jj] = e; sum += e; }
  sum += __shfl_xor(sum, 16); sum += __shfl_xor(sum, 32);
  const float inv = 1.0f / (sum + __expf(sink - mx));
  __syncthreads();
  LAS unsigned char* Pw = lds + K_OFF + wid * PWAVE;
#pragma unroll
  for (int tt = 0; tt < 9; ++tt) *(LAS u32x2*)(Pw + fr * PLD + (tt * 16 + fq * 4) * 2) = (u32x2){cvt_pk_bf16(S[tt][0] * inv, S[tt][1] * inv), cvt_pk_bf16(S[tt][2] * inv, S[tt][3] * inv)};
  *(LAS u32x2*)(Pw + fr * PLD + (9 * 16 + fq * 4) * 2) = (u32x2){0u, 0u};
  __syncthreads();
  f32x4 O[8];
#pragma unroll
  for (int nt = 0; nt < 8; ++nt) O[nt] = (f32x4){0.f, 0.f, 0.f, 0.f};
#pragma unroll
  for (int ks = 0; ks < 5; ++ks) { const bf16x8 pa = *(const LAS bf16x8*)(Pw + fr * PLD + (ks * 32 + fq * 8) * 2);
#pragma unroll
    for (int nt = 0; nt < 8; ++nt) { const int kp0 = wid * 8 + ks * 16 + fq * 4, kps = kp0 < 128 ? (kp0 ^ ((nt * 2 + (fr >> 3)) << 2)) : kp0;
      const bf16x8 vb = *(const LAS bf16x8*)(lds + V_OFF + (nt * 16 + fr) * VLD + kps * 4); O[nt] = MFMA16(vb, pa, O[nt]); } }
#pragma unroll
  for (int nt = 0; nt < 8; ++nt) *(LAS u32x2*)(Pw + fr * PLD + (nt * 16 + fq * 4) * 2) = (u32x2){cvt_pk_bf16(O[nt][0], O[nt][1]), cvt_pk_bf16(O[nt][2], O[nt][3])};
  wave_store_rows16(Pw, PLD, MIX + (size_t)(tok0 + wid * 16) * DM + h * 128, DM, lane);
  __syncthreads();
}

__device__ __forceinline__ void stage_vt128(const bf16_t* Z, int tok0, int col, LAS unsigned char* dst) {
  const int tid = opaque_tid(), c = tid & 15;
#pragma unroll
  for (int i = 0; i < 2; ++i) { const int kp = (tid >> 4) + 32 * i; const bf16_t* vp = Z + (size_t)(tok0 + 2 * kp) * NIN + col + c * 8;
    const u32x4 r0 = *(const u32x4*)vp, r1 = *(const u32x4*)(vp + NIN);
#pragma unroll
    for (int e = 0; e < 8; ++e) *(LAS unsigned*)(dst + (c * 8 + e) * LDR + (kp ^ (c << 2)) * 4) = half_of(r0, e) | (half_of(r1, e) << 16); }
}
__device__ __forceinline__ void retkv_item(const Params& p, LAS unsigned char* lds, int item) {
  constexpr int KT_OFF = 0, VT_OFF = 128 * LDR;
  const int tid = opaque_tid(), wid = __builtin_amdgcn_readfirstlane(tid >> 6), lane = tid & 63, fr = lane & 15, fq = lane >> 4;
  const int bh = item >> 5, c = item & 31, b = bh >> 3, h = bh & 7;
  const bf16_t* Z = (const bf16_t*)(p.ws + BUF_Z);
  const float* rc = (const float*)(p.ws + BUF_ROPE); const float* rsn = rc + 4097 * 64;
  bf16_t* KV = (bf16_t*)(p.ws + BUF_KV16);
  const int tok0 = b * SEQ + c * 128; const float lg = ret_lg(h);
  {
    const int cc = tid & 7, kp = tid >> 3, n0 = 2 * kp;
    float a1[8], a2[8], b1[8], b2[8];
    rot16(Z + (size_t)(tok0 + n0) * NIN + ZC_RK + h * 128, cc, rc, rsn, c * 128 + n0, RET_K_SCALE * __expf(lg * (float)(127 - n0)), a1, a2);
    rot16(Z + (size_t)(tok0 + n0 + 1) * NIN + ZC_RK + h * 128, cc, rc, rsn, c * 128 + n0 + 1, RET_K_SCALE * __expf(lg * (float)(126 - n0)), b1, b2);
#pragma unroll
    for (int e = 0; e < 8; ++e) { *(LAS unsigned*)(lds + KT_OFF + (cc * 8 + e) * LDR + (kp ^ (cc << 3)) * 4) = cvt_pk_bf16(a1[e], b1[e]);
      *(LAS unsigned*)(lds + KT_OFF + (64 + cc * 8 + e) * LDR + (kp ^ (cc << 3)) * 4) = cvt_pk_bf16(a2[e], b2[e]); }
  }
  stage_vt128(Z, tok0, ZC_RV + h * 128, lds + VT_OFF);
  __syncthreads();
  f32x4 acc[8];
#pragma unroll
  for (int nt = 0; nt < 8; ++nt) acc[nt] = (f32x4){0.f, 0.f, 0.f, 0.f};
#pragma unroll
  for (int ks = 0; ks < 4; ++ks) { const int kp0 = ks * 16 + fq * 4;
    const bf16x8 a = *(const LAS bf16x8*)(lds + KT_OFF + (wid * 16 + fr) * LDR + (kp0 ^ (((wid * 2 + (fr >> 3)) & 7) << 3)) * 4);
#pragma unroll
    for (int nt = 0; nt < 8; ++nt) { const bf16x8 vb = *(const LAS bf16x8*)(lds + VT_OFF + (nt * 16 + fr) * LDR + (kp0 ^ ((nt * 2 + (fr >> 3)) << 2)) * 4); acc[nt] = MFMA16(vb, a, acc[nt]); } }
  LAS unsigned char* wb = lds + KT_OFF + (wid * 16) * LDR;
#pragma unroll
  for (int nt = 0; nt < 8; ++nt) *(LAS u32x2*)(wb + fr * LDR + (nt * 16 + fq * 4) * 2) = (u32x2){cvt_pk_bf16(acc[nt][0], acc[nt][1]), cvt_pk_bf16(acc[nt][2], acc[nt][3])};
  wave_store_rows16(wb, LDR, KV + (size_t)item * 16384 + (wid * 16) * 128, 128, lane);
  __syncthreads();
}

__device__ __forceinline__ void phase_scan(const Params& p) {
  const u32x2* KV = (const u32x2*)(p.ws + BUF_KV16);
  const size_t gtid = (size_t)blockIdx.x * 512 + threadIdx.x, gstride = (size_t)gridDim.x * 512;
  for (size_t idx = gtid; idx < (size_t)16 * 4096; idx += gstride) {
    const int bh = (int)(idx >> 12), e4 = (int)(idx & 4095), h = bh & 7;
    const float dec = __expf(ret_lg(h) * 128.0f);
    const u32x2* base = KV + (size_t)bh * 32 * 4096 + e4; u32x2* s16 = (u32x2*)(p.ws + BUF_S16) + (size_t)bh * 32 * 4096 + e4;
    u32x2 v[32];
#pragma unroll
    for (int c = 0; c < 32; ++c) v[c] = base[(size_t)c * 4096];
    f32x4 s = (f32x4){0.f, 0.f, 0.f, 0.f};
#pragma unroll
    for (int c = 0; c < 32; ++c) { s16[(size_t)c * 4096] = (u32x2){cvt_pk_bf16(s[0], s[1]), cvt_pk_bf16(s[2], s[3])};
      s = s * dec + (f32x4){bf_lo(v[c].x), bf_hi(v[c].x), bf_lo(v[c].y), bf_hi(v[c].y)}; }
    *(f32x4*)(p.out + O_RSP + (size_t)bh * 16384 + e4 * 4) = s;
  }
}

__device__ __forceinline__ void retout_item(const Params& p, LAS unsigned char* lds, int item) {
  constexpr int Q_OFF = 0, K_OFF = 128 * LDR, VT_OFF = 256 * LDR, ST_OFF = 384 * LDR;
  const int tid = opaque_tid(), wid = __builtin_amdgcn_readfirstlane(tid >> 6), lane = tid & 63, fr = lane & 15, fq = lane >> 4;
  const int bh = item >> 5, c = item & 31, b = bh >> 3, h = bh & 7;
  const bf16_t* Z = (const bf16_t*)(p.ws + BUF_Z);
  bf16_t* MIX = (bf16_t*)(p.ws + BUF_MIX);
  const float* rc = (const float*)(p.ws + BUF_ROPE); const float* rsn = rc + 4097 * 64;
  const bf16_t* SP = (const bf16_t*)(p.ws + BUF_S16) + (size_t)item * 16384;
  const int tok0 = b * SEQ + c * 128; const float lg = ret_lg(h);
  {
    const int cc = tid & 7;
#pragma unroll
    for (int i = 0; i < 2; ++i) { const int n = (tid >> 3) + 64 * i; float o1[8], o2[8];
      rot16(Z + (size_t)(tok0 + n) * NIN + ZC_RQ + h * 128, cc, rc, rsn, c * 128 + n, 1.0f, o1, o2);
      *(LAS u32x4*)(lds + Q_OFF + n * LDR + cc * 16) = pack8(o1); *(LAS u32x4*)(lds + Q_OFF + n * LDR + (cc + 8) * 16) = pack8(o2);
      rot16(Z + (size_t)(tok0 + n) * NIN + ZC_RK + h * 128, cc, rc, rsn, c * 128 + n, RET_K_SCALE, o1, o2);
      *(LAS u32x4*)(lds + K_OFF + n * LDR + cc * 16) = pack8(o1); *(LAS u32x4*)(lds + K_OFF + n * LDR + (cc + 8) * 16) = pack8(o2); }
  }
  stage_vt128(Z, tok0, ZC_RV + h * 128, lds + VT_OFF);
  {
    const int c16 = tid & 15;
#pragma unroll
    for (int i = 0; i < 2; ++i) { const int kp = (tid >> 4) + 32 * i; const bf16_t* sp = SP + (size_t)(2 * kp) * 128 + c16 * 8;
      const u32x4 r0 = *(const u32x4*)sp, r1 = *(const u32x4*)(sp + 128);
#pragma unroll
      for (int e = 0; e < 8; ++e) *(LAS unsigned*)(lds + ST_OFF + (c16 * 8 + e) * LDR + (kp ^ (c16 << 2)) * 4) = half_of(r0, e) | (half_of(r1, e) << 16); }
  }
  __syncthreads();
  const int n = wid * 16 + fr;
  bf16x8 Qa[4];
#pragma unroll
  for (int ks = 0; ks < 4; ++ks) Qa[ks] = *(const LAS bf16x8*)(lds + Q_OFF + n * LDR + (ks * 32 + fq * 8) * 2);
  f32x4 O[8];
#pragma unroll
  for (int nt = 0; nt < 8; ++nt) O[nt] = (f32x4){0.f, 0.f, 0.f, 0.f};
#pragma unroll
  for (int ks = 0; ks < 4; ++ks)
#pragma unroll
    for (int nt = 0; nt < 8; ++nt) { const bf16x8 sb = *(const LAS bf16x8*)(lds + ST_OFF + (nt * 16 + fr) * LDR + ((ks * 16 + fq * 4) ^ ((nt * 2 + (fr >> 3)) << 2)) * 4); O[nt] = MFMA16(sb, Qa[ks], O[nt]); }
  const float qdec = __expf(lg * (float)(n + 1));
#pragma unroll
  for (int nt = 0; nt < 8; ++nt) O[nt] *= qdec;
  f32x4 SC[8];
#pragma unroll
  for (int tt = 0; tt < 8; ++tt) { SC[tt] = (f32x4){0.f, 0.f, 0.f, 0.f};
    if (tt <= wid) {
#pragma unroll
      for (int ks = 0; ks < 4; ++ks) { const bf16x8 kb = *(const LAS bf16x8*)(lds + K_OFF + (tt * 16 + fr) * LDR + (ks * 32 + fq * 8) * 2); SC[tt] = MFMA16(kb, Qa[ks], SC[tt]); } } }
  __syncthreads();
#pragma unroll
  for (int tt = 0; tt < 8; ++tt) { float pv[4];
#pragma unroll
    for (int jj = 0; jj < 4; ++jj) { const int e = tt * 16 + fq * 4 + jj; pv[jj] = (e <= n) ? SC[tt][jj] * __expf(lg * (float)(n - e)) : 0.f; }
    *(LAS u32x2*)(lds + K_OFF + n * LDR + (tt * 16 + fq * 4) * 2) = (u32x2){cvt_pk_bf16(pv[0], pv[1]), cvt_pk_bf16(pv[2], pv[3])}; }
  __syncthreads();
#pragma unroll
  for (int ks = 0; ks < 4; ++ks) { const bf16x8 pa = *(const LAS bf16x8*)(lds + K_OFF + n * LDR + (ks * 32 + fq * 8) * 2);
#pragma unroll
    for (int nt = 0; nt < 8; ++nt) { const bf16x8 vb = *(const LAS bf16x8*)(lds + VT_OFF + (nt * 16 + fr) * LDR + ((ks * 16 + fq * 4) ^ ((nt * 2 + (fr >> 3)) << 2)) * 4); O[nt] = MFMA16(vb, pa, O[nt]); } }
  float ss = 0.f;
#pragma unroll
  for (int nt = 0; nt < 8; ++nt) ss += O[nt][0] * O[nt][0] + O[nt][1] * O[nt][1] + O[nt][2] * O[nt][2] + O[nt][3] * O[nt][3];
  ss += __shfl_xor(ss, 16); ss += __shfl_xor(ss, 32);
  const float r = rsqrtf(ss * (1.0f / 128.0f) + EPS);
  LAS unsigned char* wb = lds + K_OFF + (wid * 16) * LDR;
  u32x4 graw[4];
#pragma unroll
  for (int i = 0; i < 4; ++i) graw[i] = *(const u32x4*)(Z + (size_t)(tok0 + wid * 16 + (lane >> 4) + 4 * i) * NIN + ZC_RG + h * 128 + (lane & 15) * 8);
#pragma unroll
  for (int nt = 0; nt < 8; ++nt) { const f32x4 rg = *(const f32x4*)(p.rg + h * 128 + nt * 16 + fq * 4);
    *(LAS u32x2*)(wb + fr * LDR + (nt * 16 + fq * 4) * 2) = (u32x2){cvt_pk_bf16(O[nt][0] * r * rg[0], O[nt][1] * r * rg[1]), cvt_pk_bf16(O[nt][2] * r * rg[2], O[nt][3] * r * rg[3])}; }
#pragma unroll
  for (int i = 0; i < 4; ++i) { const int row = (lane >> 4) + 4 * i, ch = lane & 15;
    float y[8], g[8]; unpack8(*(const LAS u32x4*)(wb + row * LDR + ch * 16), y); unpack8(graw[i], g);
#pragma unroll
    for (int e2 = 0; e2 < 8; ++e2) y[e2] *= silu_f(g[e2]);
    *(u32x4*)(MIX + (size_t)(tok0 + wid * 16 + row) * DM + 1024 + h * 128 + ch * 8) = pack8(y); }
  __syncthreads();
}
__device__ __forceinline__ void sample_item(const Params& p, LAS unsigned char* lds, int item) {
  const int tid = opaque_tid(), wid = __builtin_amdgcn_readfirstlane(tid >> 6), lane = tid & 63;
  int b, h;
  if (gridDim.x == 256) { const int x = item & 7, y = item >> 3, g = x * 8 + (y >> 2); b = g >> 1; h = (g & 1) * 4 + (y & 3); }
  else { b = item >> 3; h = item & 7; }
  const int kvh = h >> 2, R = NTOK_P + b;
  const bf16_t* zr = (const bf16_t*)(p.ws + BUF_Z) + (size_t)R * NIN;
  bf16_t* mixr = (bf16_t*)(p.ws + BUF_MIX) + (size_t)R * DM;
  LAS float* qs = (LAS float*)lds; LAS float* ks = qs + 128; LAS float* vs = qs + 256; LAS float* sc = qs + 384; LAS float* pr = qs + 528; LAS float* part = qs + 672;
  LAS float* qr = qs + 2720; LAS float* kr = qr + 128; LAS float* vv = qr + 256; LAS float* gg = qr + 384;
  const float* rc = (const float*)(p.ws + BUF_ROPE) + 4096 * 64; const float* rsn = rc + 4097 * 64;
  if (wid == 0) { const float a0 = bf2f(zr[ZC_AQ + h * 128 + lane]), a1 = bf2f(zr[ZC_AQ + h * 128 + lane + 64]); const float r = rsqrtf(wave_sum(a0 * a0 + a1 * a1) * (1.0f / 128.0f) + EPS);
    qs[lane] = a0 * r * p.qn[lane]; qs[lane + 64] = a1 * r * p.qn[lane + 64]; }
  else if (wid == 1) { const float a0 = bf2f(zr[ZC_AK + kvh * 128 + lane]), a1 = bf2f(zr[ZC_AK + kvh * 128 + lane + 64]); const float r = rsqrtf(wave_sum(a0 * a0 + a1 * a1) * (1.0f / 128.0f) + EPS);
    ks[lane] = a0 * r * p.kn[lane]; ks[lane + 64] = a1 * r * p.kn[lane + 64]; }
  else if (wid == 2) { vs[lane] = bf2f(zr[ZC_AV + kvh * 128 + lane]); vs[lane + 64] = bf2f(zr[ZC_AV + kvh * 128 + lane + 64]); }
  else if (wid == 3) { const float x1 = bf2f(zr[ZC_RQ + h * 128 + lane]), x2 = bf2f(zr[ZC_RQ + h * 128 + lane + 64]); const float cs = rc[lane], sn = rsn[lane];
    qr[lane] = x1 * cs - x2 * sn; qr[lane + 64] = x1 * sn + x2 * cs; }
  else if (wid == 4) { const float x1 = bf2f(zr[ZC_RK + h * 128 + lane]), x2 = bf2f(zr[ZC_RK + h * 128 + lane + 64]); const float cs = rc[lane], sn = rsn[lane];
    kr[lane] = (x1 * cs - x2 * sn) * RET_K_SCALE; kr[lane + 64] = (x1 * sn + x2 * cs) * RET_K_SCALE; }
  else if (wid == 5) { vv[lane] = bf2f(zr[ZC_RV + h * 128 + lane]); vv[lane + 64] = bf2f(zr[ZC_RV + h * 128 + lane + 64]); }
  else if (wid == 6) { gg[lane] = bf2f(zr[ZC_RG + h * 128 + lane]); gg[lane + 64] = bf2f(zr[ZC_RG + h * 128 + lane + 64]); }
  __syncthreads();
  {
    const int ch = lane & 31, hf = lane >> 5;
    const f32x4 qv = (f32x4){qs[ch * 4], qs[ch * 4 + 1], qs[ch * 4 + 2], qs[ch * 4 + 3]};
    f32x4 kvv[8];
#pragma unroll
    for (int i = 0; i < 8; ++i) kvv[i] = *(const f32x4*)(p.ck + ((size_t)(b * 128 + wid * 16 + i * 2 + hf) * 2 + kvh) * 128 + ch * 4);
#pragma unroll
    for (int i = 0; i < 8; ++i) { float dd = kvv[i][0] * qv[0] + kvv[i][1] * qv[1] + kvv[i][2] * qv[2] + kvv[i][3] * qv[3];
      dd += __shfl_xor(dd, 1); dd += __shfl_xor(dd, 2); dd += __shfl_xor(dd, 4); dd += __shfl_xor(dd, 8); dd += __shfl_xor(dd, 16);
      if (ch == 0) sc[wid * 16 + i * 2 + hf] = dd * ATTN_SCALE; }
    if (wid == 0) { const float dn = wave_sum(qs[lane] * ks[lane] + qs[lane + 64] * ks[lane + 64]); if (lane == 0) sc[128] = dn * ATTN_SCALE; }
  }
  __syncthreads();
  if (wid == 0) { const float sink = p.sinks[h]; const float s0 = sc[lane], s1 = sc[lane + 64], s2 = lane == 0 ? sc[128] : -INFINITY;
    const float mx = fmaxf(wave_max(fmaxf(fmaxf(s0, s1), s2)), sink);
    const float e0 = __expf(s0 - mx), e1 = __expf(s1 - mx), e2 = __expf(s2 - mx);
    const float inv = 1.0f / (wave_sum(e0 + e1 + e2) + __expf(sink - mx));
    pr[lane] = e0 * inv; pr[lane + 64] = e1 * inv; if (lane == 0) pr[128] = e2 * inv; }
  __syncthreads();
  {
    const int ch = lane & 31, hf = lane >> 5;
    f32x4 vvv[8];
#pragma unroll
    for (int i = 0; i < 8; ++i) vvv[i] = *(const f32x4*)(p.cv + ((size_t)(b * 128 + wid * 16 + i * 2 + hf) * 2 + kvh) * 128 + ch * 4);
    f32x4 a4 = (f32x4){0.f, 0.f, 0.f, 0.f};
#pragma unroll
    for (int i = 0; i < 8; ++i) a4 += vvv[i] * pr[wid * 16 + i * 2 + hf];
#pragma unroll
    for (int j = 0; j < 4; ++j) a4[j] += __shfl_xor(a4[j], 32);
    if (hf == 0) { part[wid * 128 + ch * 4] = a4[0]; part[wid * 128 + ch * 4 + 1] = a4[1]; part[wid * 128 + ch * 4 + 2] = a4[2]; part[wid * 128 + ch * 4 + 3] = a4[3]; }
  }
  __syncthreads();
  if (tid < 128) { float o = pr[128] * vs[tid];
#pragma unroll
    for (int w = 0; w < 8; ++w) o += part[w * 128 + tid];
    mixr[h * 128 + tid] = (bf16_t)(cvt_pk_bf16(o, 0.f) & 0xffffu); }
  if ((h & 3) == 0) {
    for (int idx = tid; idx < 128 * 32; idx += 512) { const int w = idx >> 5, d4 = (idx & 31) * 4;
      const size_t src = ((size_t)(b * 128 + w + 1) * 2 + kvh) * 128 + d4, dst = ((size_t)(b * 128 + w) * 2 + kvh) * 128 + d4;
      f32x4 kx, vx;
      if (w < 127) { kx = *(const f32x4*)(p.ck + src); vx = *(const f32x4*)(p.cv + src); }
      else { kx = (f32x4){ks[d4], ks[d4 + 1], ks[d4 + 2], ks[d4 + 3]}; vx = (f32x4){vs[d4], vs[d4 + 1], vs[d4 + 2], vs[d4 + 3]}; }
      __builtin_nontemporal_store(kx, (f32x4*)(p.out + O_KWS + dst)); __builtin_nontemporal_store(vx, (f32x4*)(p.out + O_VWS + dst)); }
  }
  __syncthreads();
  {
    const float gamma = 1.0f - exp2f(-5.0f - (float)h);
    const int dv4 = (tid & 31) * 4, dkg = tid >> 5;
    const f32x4 v4 = (f32x4){vv[dv4], vv[dv4 + 1], vv[dv4 + 2], vv[dv4 + 3]};
    f32x4 o4 = (f32x4){0.f, 0.f, 0.f, 0.f};
#pragma unroll
    for (int i = 0; i < 8; ++i) { const int dk = dkg + 16 * i; const size_t off = ((size_t)(b * 8 + h) * 128 + dk) * 128 + dv4;
      const f32x4 sn = __builtin_nontemporal_load((const f32x4*)(p.st + off)) * gamma + v4 * kr[dk];
      __builtin_nontemporal_store(sn, (f32x4*)(p.out + O_RSS + off)); o4 += sn * qr[dk]; }
    part[dkg * 128 + dv4] = o4[0]; part[dkg * 128 + dv4 + 1] = o4[1]; part[dkg * 128 + dv4 + 2] = o4[2]; part[dkg * 128 + dv4 + 3] = o4[3];
  }
  __syncthreads();
  if (wid == 0) { float o0 = 0.f, o1 = 0.f;
#pragma unroll
    for (int g = 0; g < 16; ++g) { o0 += part[g * 128 + lane]; o1 += part[g * 128 + lane + 64]; }
    const float r = rsqrtf(wave_sum(o0 * o0 + o1 * o1) * (1.0f / 128.0f) + EPS);
    const float y0 = o0 * r * p.rg[h * 128 + lane] * silu_f(gg[lane]), y1 = o1 * r * p.rg[h * 128 + lane + 64] * silu_f(gg[lane + 64]);
    mixr[1024 + h * 128 + lane] = (bf16_t)(cvt_pk_bf16(y0, 0.f) & 0xffffu); mixr[1024 + h * 128 + lane + 64] = (bf16_t)(cvt_pk_bf16(y1, 0.f) & 0xffffu); }
  __syncthreads();
}


template <int NB, int U>
__device__ __forceinline__ void skinny_mma(const bf16_t* A, const bf16_t* B0, const bf16_t* B1, int K, LAS float* red, float (&out)[NB]) {
  const int tid = opaque_tid(), wid = __builtin_amdgcn_readfirstlane(tid >> 6), lane = tid & 63, fr = lane & 15, fq = lane >> 4;
  const int kw = K >> 3, nks = kw >> 5;
  f32x4 acc[NB][2];
#pragma unroll
  for (int nb = 0; nb < NB; ++nb) { acc[nb][0] = (f32x4){0.f, 0.f, 0.f, 0.f}; acc[nb][1] = (f32x4){0.f, 0.f, 0.f, 0.f}; }
  const size_t off = (size_t)fr * K + wid * kw + fq * 8;
  const bf16_t* a0p = A + off; const bf16_t* a1p = a0p + (size_t)16 * K; const bf16_t* b0p = B0 + off; const bf16_t* b1p = B1 + off;
  for (int ks0 = 0; ks0 < nks; ks0 += U) {
    bf16x8 a0[U], a1[U], b0[U], b1[U];
#pragma unroll
    for (int u = 0; u < U; ++u) { a0[u] = *(const bf16x8*)(a0p + (ks0 + u) * 32); a1[u] = *(const bf16x8*)(a1p + (ks0 + u) * 32); b0[u] = *(const bf16x8*)(b0p + (ks0 + u) * 32);
      if (NB == 2) b1[u] = *(const bf16x8*)(b1p + (ks0 + u) * 32); else b1[u] = b0[u]; }
#pragma unroll
    for (int u = 0; u < U; ++u) { acc[0][0] = MFMA16(b0[u], a0[u], acc[0][0]); acc[0][1] = MFMA16(b0[u], a1[u], acc[0][1]);
      if (NB == 2) { acc[NB - 1][0] = MFMA16(b1[u], a0[u], acc[NB - 1][0]); acc[NB - 1][1] = MFMA16(b1[u], a1[u], acc[NB - 1][1]); } }
  }
#pragma unroll
  for (int nb = 0; nb < NB; ++nb)
#pragma unroll
    for (int hf = 0; hf < 2; ++hf) *(LAS f32x4*)(red + ((nb * 8 + wid) * 32 + hf * 16 + fr) * 16 + fq * 4) = acc[nb][hf];
  __syncthreads();
  const int row = tid >> 4, col = tid & 15;
#pragma unroll
  for (int nb = 0; nb < NB; ++nb) { float s = 0.f;
#pragma unroll
    for (int w = 0; w < 8; ++w) s += red[((nb * 8 + w) * 32 + row) * 16 + col];
    out[nb] = s; }
  __syncthreads();
}
#define SKINNY_LOOP(ntasks, nwg) const int _r = (nwg) % G, _nb = _r ? G - _r : G; const int _me = G - 1 - bid; if (_me < _nb) for (int task = _me; task < (ntasks); task += _nb)

__device__ __forceinline__ void skinny_p1(const Params& p, LAS unsigned char* lds, int G, int bid) {
  unsigned char* ws = p.ws; const int tid = opaque_tid(), row = tid >> 4, col = tid & 15;
  SKINNY_LOOP(NIN / 16, (NTOK_P / 256) * (NIN / 256)) { const int c0 = task * 16; float v[1];
    skinny_mma<1, 8>((const bf16_t*)(ws + BUF_A) + (size_t)NTOK_P * DM, (const bf16_t*)(ws + W_IN) + (size_t)c0 * DM, nullptr, DM, (LAS float*)lds, v);
    ((bf16_t*)(ws + BUF_Z))[(size_t)(NTOK_P + row) * NIN + c0 + col] = (bf16_t)(cvt_pk_bf16(v[0], 0.f) & 0xffffu); }
}
__device__ __forceinline__ void skinny_p3(const Params& p, LAS unsigned char* lds, int G, int bid) {
  unsigned char* ws = p.ws; const int tid = opaque_tid(), row = tid >> 4, col = tid & 15; float* rs1 = (float*)(ws + BUF_RS);
  SKINNY_LOOP(DM / 16, (NTOK_P / 256) * (DM / 256)) { const int c = task * 16 + col; float v[1];
    skinny_mma<1, 8>((const bf16_t*)(ws + BUF_MIX) + (size_t)NTOK_P * DM, (const bf16_t*)(ws + W_OUT) + (size_t)(task * 16) * DM, nullptr, DM, (LAS float*)lds, v);
    const float hn = p.x_s[(size_t)row * DM + c] + v[0];
    ((bf16_t*)(ws + BUF_B))[(size_t)(NTOK_P + row) * DM + c] = (bf16_t)(cvt_pk_bf16(hn * p.fn[c], 0.f) & 0xffffu);
    float ss = hn * hn; ss += __shfl_xor(ss, 1); ss += __shfl_xor(ss, 2); ss += __shfl_xor(ss, 4); ss += __shfl_xor(ss, 8);
    if (col == 0) atomicAdd(rs1 + NTOK_P + row, ss); }
}
__device__ __forceinline__ void skinny_p5(const Params& p, LAS unsigned char* lds, int G, int bid) {
  unsigned char* ws = p.ws; const int tid = opaque_tid(), row = tid >> 4, col = tid & 15; float* rs2 = (float*)(ws + BUF_RS) + M_PAD;
  SKINNY_LOOP(DM / 16, (NTOK_P / 256) * (DM / 256)) { const int c = task * 16 + col; float v[1];
    skinny_mma<1, 11>((const bf16_t*)(ws + BUF_Z) + (size_t)NTOK_P * DFF, (const bf16_t*)(ws + W_DOWN) + (size_t)(task * 16) * DFF, nullptr, DFF, (LAS float*)lds, v);
    const float hn = bf2f(((const bf16_t*)(ws + BUF_B))[(size_t)(NTOK_P + row) * DM + c]) / p.fn[c] + v[0];
    ((bf16_t*)(ws + BUF_A))[(size_t)(NTOK_P + row) * DM + c] = (bf16_t)(cvt_pk_bf16(hn * p.pn[c], 0.f) & 0xffffu);
    float ss = hn * hn; ss += __shfl_xor(ss, 1); ss += __shfl_xor(ss, 2); ss += __shfl_xor(ss, 4); ss += __shfl_xor(ss, 8);
    if (col == 0) atomicAdd(rs2 + NTOK_P + row, ss); }
}
__device__ __forceinline__ void skinny_p4(const Params& p, LAS unsigned char* lds, int G, int bid) {
  unsigned char* ws = p.ws; const int tid = opaque_tid(), row = tid >> 4, col = tid & 15; const float* rs1 = (const float*)(ws + BUF_RS);
  SKINNY_LOOP(DFF / 16, (NTOK_P / 256) * (2 * DFF / 256)) { const int c0 = task * 16, gr = (c0 >> 7) * 256 + (c0 & 127); float v[2];
    skinny_mma<2, 8>((const bf16_t*)(ws + BUF_B) + (size_t)NTOK_P * DM, (const bf16_t*)(ws + W_GU) + (size_t)gr * DM, (const bf16_t*)(ws + W_GU) + (size_t)(gr + 128) * DM, DM, (LAS float*)lds, v);
    const float r = rsqrtf(rs1[NTOK_P + row] * (1.0f / DM) + EPS);
    ((bf16_t*)(ws + BUF_Z))[(size_t)(NTOK_P + row) * DFF + c0 + col] = (bf16_t)(cvt_pk_bf16(silu_f(v[0] * r) * (v[1] * r), 0.f) & 0xffffu); }
}
__device__ __forceinline__ void skinny_p6(const Params& p, LAS unsigned char* lds, int G, int bid) {
  unsigned char* ws = p.ws; const int tid = opaque_tid(), row = tid >> 4, col = tid & 15; const float* rs2 = (const float*)(ws + BUF_RS) + M_PAD;
  SKINNY_LOOP(DM / 16, (NTOK_P / 256) * (DM / 256)) { const int c0 = task * 16; float v[1], t[1];
    skinny_mma<1, 8>((const bf16_t*)(ws + BUF_A) + (size_t)NTOK_P * DM, (const bf16_t*)(ws + W_PG) + (size_t)c0 * DM, nullptr, DM, (LAS float*)lds, v);
    skinny_mma<1, 1>((const bf16_t*)(ws + BUF_P) + (size_t)NTOK_P * PLE, (const bf16_t*)(ws + W_PLE) + (size_t)c0 * PLE, nullptr, PLE, (LAS float*)lds, t);
    const float r = rsqrtf(rs2[NTOK_P + row] * (1.0f / DM) + EPS);
    const int c = c0 + col; const float h2 = bf2f(((const bf16_t*)(ws + BUF_A))[(size_t)(NTOK_P + row) * DM + c]) / p.pn[c];
    p.out[O_YS + (size_t)row * DM + c] = h2 + t[0] * sigmoid_f(v[0] * r); }
}

__device__ __forceinline__ void tail_wout(const Params& p, LAS unsigned char* lds, int G, int bid) {
  const int r = ((NTOK_P / 256) * (NIN / 256)) % G, nb = r ? G - r : G, me = G - 1 - bid;
  if (me < nb) transpose_jobs<1>(p, lds, me, nb);
}
__device__ __forceinline__ void tail_wdown(const Params& p, LAS unsigned char* lds, int G, int bid) {
  const int r = ((NTOK_P / 256) * (2 * DFF / 256)) % G, nb = r ? G - r : G, me = G - 1 - bid;
  if (me < nb) transpose_jobs<2>(p, lds, me, nb);
}

__global__ void __launch_bounds__(512, 2) hybrid_fwd(Params p) {
  extern __shared__ __attribute__((aligned(16))) unsigned char shm[];
  cg::grid_group grid = cg::this_grid();
  LAS unsigned char* lds = (LAS unsigned char*)shm;
  unsigned char* ws = p.ws;
  const int G = (int)gridDim.x, bid = (int)blockIdx.x;
  bf16_t* bufA = (bf16_t*)(ws + BUF_A); bf16_t* bufB = (bf16_t*)(ws + BUF_B); bf16_t* bufZ = (bf16_t*)(ws + BUF_Z);
  float* rs1 = (float*)(ws + BUF_RS); float* rs2 = rs1 + M_PAD;
  volatile LAS unsigned* st = (volatile LAS unsigned*)(lds + LDS_PHASE_BYTES);
  if (threadIdx.x == 0) { st[0] = 0u; st[1] = 0u; }
  __syncthreads();
  const XcdBarrier xb = xcd_barrier_post((unsigned*)(ws + BUF_BAR), st);

  phase_prep(p, lds);
  if (p.never) grid.sync();
  xcd_barrier(xb);
  { Gemm g{bufA, (const bf16_t*)(ws + W_IN), NTOK_P, NIN, DM}; StaticOrder S; S.init(NTOK_P, NIN, G, bid); EpiZ E{bufZ, NIN};
    gemm_phase<EpiZ, StaticOrder, false>(lds, g, S, E, nullptr); }
  skinny_p1(p, lds, G, bid);
  tail_wout(p, lds, G, bid);
  xcd_barrier(xb);
  for (int it = bid; it < 1280; it += G) { if (it < 512) attn_item(p, lds, it); else if (it < 1024) retkv_item(p, lds, it - 512); else sample_item(p, lds, it - 1024); }
  xcd_barrier(xb);
  phase_scan(p);
  xcd_barrier(xb);
  for (int it = bid; it < 512; it += G) retout_item(p, lds, it);
  xcd_barrier(xb);
  { Gemm g{(const bf16_t*)(ws + BUF_MIX), (const bf16_t*)(ws + W_OUT), NTOK_P, DM, DM}; StaticOrder S; S.init(NTOK_P, DM, G, bid); EpiRes3 E{bufA, (const float*)(ws + BUF_XS), p.an, bufB, p.fn, rs1};
    gemm_phase<EpiRes3, StaticOrder, false>(lds, g, S, E, nullptr); }
  skinny_p3(p, lds, G, bid);
  xcd_barrier(xb);
  { Gemm g{bufB, (const bf16_t*)(ws + W_GU), NTOK_P, 2 * DFF, DM}; StaticOrder S; S.init(NTOK_P, 2 * DFF, G, bid); EpiAct E{bufZ, rs1};
    gemm_phase<EpiAct, StaticOrder, false>(lds, g, S, E, nullptr); }
  skinny_p4(p, lds, G, bid);
  tail_wdown(p, lds, G, bid);
  xcd_barrier(xb);
  { Gemm g{bufZ, (const bf16_t*)(ws + W_DOWN), NTOK_P, DM, DFF}; StaticOrder S; S.init(NTOK_P, DM, G, bid); EpiRes5 E{bufB, p.fn, bufA, p.pn, rs2};
    gemm_phase<EpiRes5, StaticOrder, false>(lds, g, S, E, nullptr); }
  { Gemm g{(const bf16_t*)(ws + BUF_P), (const bf16_t*)(ws + W_PLE), NTOK_P, DM, PLE}; StaticOrder S; S.init(NTOK_P, DM, G, bid); EpiZ E{bufB, DM};
    gemm_phase<EpiZ, StaticOrder, false>(lds, g, S, E, nullptr); }
  skinny_p5(p, lds, G, bid);
  xcd_barrier(xb);
  { Gemm g{bufA, (const bf16_t*)(ws + W_PG), NTOK_P, DM, DM}; StaticOrder S; S.init(NTOK_P, DM, G, bid); EpiPle E{p.out, bufA, p.pn, bufB, rs2};
    gemm_phase<EpiPle, StaticOrder, false>(lds, g, S, E, nullptr); }
  skinny_p6(p, lds, G, bid);
}

extern "C" void kernel_launch(void* const* d_in, const int* in_sizes, int n_in, void* d_out, int out_size, void* d_ws, size_t ws_size, hipStream_t stream) {
  static int grid_blocks = 0;
  if (!grid_blocks) {
    int dev = 0, cus = 0, per_cu = 0;
    (void)hipGetDevice(&dev);
    (void)hipDeviceGetAttribute(&cus, hipDeviceAttributeMultiprocessorCount, dev);
    (void)hipFuncSetAttribute((const void*)hybrid_fwd, hipFuncAttributeMaxDynamicSharedMemorySize, LDS_BYTES);
    (void)hipOccupancyMaxActiveBlocksPerMultiprocessor(&per_cu, hybrid_fwd, 512, (size_t)LDS_BYTES);
    if (per_cu < 1) per_cu = 1;
    grid_blocks = cus * per_cu;
    if (ws_size < WS_END) fprintf(stderr, "workspace too small: %zu < %zu\n", ws_size, (size_t)WS_END);
  }
  Params p{};
  p.x_p = (const float*)d_in[0]; p.x_s = (const float*)d_in[1]; p.ck = (const float*)d_in[2]; p.cv = (const float*)d_in[3]; p.st = (const float*)d_in[4];
  p.p_p = (const float*)d_in[5]; p.p_s = (const float*)d_in[6]; p.an = (const float*)d_in[7]; p.w_in = (const float*)d_in[8]; p.qn = (const float*)d_in[9];
  p.kn = (const float*)d_in[10]; p.sinks = (const float*)d_in[11]; p.rg = (const float*)d_in[12]; p.w_out = (const float*)d_in[13]; p.fn = (const float*)d_in[14];
  p.w_gate = (const float*)d_in[15]; p.w_up = (const float*)d_in[16]; p.w_down = (const float*)d_in[17]; p.pn = (const float*)d_in[18]; p.w_ple = (const float*)d_in[19];
  p.w_pg = (const float*)d_in[20]; p.out = (float*)d_out; p.ws = (unsigned char*)d_ws;
  (void)hipMemsetAsync((unsigned char*)d_ws + BUF_BAR, 0, (size_t)XCD_BAR_WORDS * 4, stream);
  void* args[] = {&p};
  hipError_t e = hipLaunchCooperativeKernel((const void*)hybrid_fwd, dim3(grid_blocks), dim3(512), args, (size_t)LDS_BYTES, stream);
  if (e != hipSuccess) fprintf(stderr, "cooperative launch failed: %s (grid %d)\n", hipGetErrorString(e), grid_blocks);
}
```

```cpp
#include <hip/hip_runtime.h>
#include <hip/hip_cooperative_groups.h>
#include <cstdio>
namespace cg = cooperative_groups;
__device__ __forceinline__ int opaque_tid() { int t = (int)threadIdx.x; asm volatile("" : "+v"(t)); return t; }
namespace pg8 {
#define PG8_LAS __attribute__((address_space(3)))
typedef unsigned short bf16_t;
typedef short bf16x8 __attribute__((ext_vector_type(8)));
typedef float f32x4 __attribute__((ext_vector_type(4)));
typedef unsigned u32x4 __attribute__((ext_vector_type(4)));
constexpr int BM = 256, BK = 64, HALF = 128, HTB = HALF * BK * 2  , STAGE_BYTES = 8 * HTB, NXCD = 8, WGM = 8;

__host__ __device__ __forceinline__ int lds_byte(int r, int c) { const int st = (r >> 4) * 2 + (c >> 5), rr = r & 15, cc = c & 31, ob = rr * 64 + cc * 2; return st * 1024 + (ob ^ (((ob >> 9) & 1) << 5)); }
__host__ __device__ __forceinline__ void stage_rc(int b, int& R, int& C) { const int st = b / 1024, sb = b % 1024, swz = sb ^ (((sb >> 9) & 1) << 5); R = (st >> 1) * 16 + swz / 64; C = (st & 1) * 32 + (swz % 64) / 2; }
__host__ __device__ __forceinline__ int perm32(int rho) { const int n = rho >> 4, i = rho & 15; return 8 * (i >> 2) + 4 * n + (i & 3); }

struct Unit { int pm, pn; };
struct Gemm { const bf16_t* A; const bf16_t* Bt; int M, N, K; };

struct StaticOrder {
    int nM, nN, nwg, G, c;
    __host__ __device__ void init(int M, int N, int G_, int c_) { nM = M / BM; nN = N / BM; nwg = nM * nN; G = G_; c = c_; }
    __host__ __device__ bool next(int i, Unit& u) const {
        const long L = (long)i * G + c; if (L >= nwg) return false;
        int wgid = (int)L; { const int q = nwg / NXCD, r = nwg % NXCD, xcd = wgid % NXCD, off = wgid / NXCD; wgid = (xcd < r ? xcd * (q + 1) : r * (q + 1) + (xcd - r) * q) + off; }
        const int nig = WGM * nN, gid = wgid / nig, fm = gid * WGM, gsz = (nM - fm) < WGM ? (nM - fm) : WGM;
        u.pm = fm + ((wgid % nig) % gsz); u.pn = (wgid % nig) / gsz; return true;
    }
    __device__ __forceinline__ void a_ready(const Unit&) const {}
    __device__ __forceinline__ void done(const Unit&) const {}
};
__device__ __forceinline__ unsigned cvt_pk_bf16(float lo, float hi) { unsigned r; asm volatile("v_cvt_pk_bf16_f32 %0, %1, %2" : "=v"(r) : "v"(lo), "v"(hi)); return r; }
template <class Epi, class Sched, bool STAMP = false>
__device__ __forceinline__ void gemm_phase(PG8_LAS unsigned char* lds, const Gemm g, const Sched& S, const Epi& E, unsigned long long* stamps) {
    const int tid = opaque_tid(), wid = __builtin_amdgcn_readfirstlane(tid >> 6), lane = tid & 63, wr = wid >> 2, wc = wid & 3, fr = lane & 15, fq = lane >> 4;
    const int K = g.K, nt = K / BK;
    int ts_lo = 0, ts_hi = 0, nts = 0; const unsigned long long rt_entry = STAMP ? (unsigned long long)wall_clock64() : 0ull;
#define PG8_STAMP() do { if (STAMP && wid == 0 && nts < 64) { const unsigned long long _c = (unsigned long long)clock64(); \
        ts_lo = (lane == nts) ? (int)(unsigned)_c : ts_lo; ts_hi = (lane == nts) ? (int)(unsigned)(_c >> 32) : ts_hi; ++nts; } } while (0)
    PG8_STAMP();
    unsigned voffA[2], voffB[2];
#pragma unroll
    for (int i = 0; i < 2; ++i) { int R, C; stage_rc(tid * 16 + i * 8192, R, C); const int Rb = Epi::PERM ? ((R & ~31) + perm32(R & 31)) : R;
        voffA[i] = (unsigned)(R * K + C) * 2u; voffB[i] = (unsigned)(Rb * K + C) * 2u; }
    const size_t kstep = (size_t)(BK * 2);
    const size_t hstep = (size_t)HALF * K * 2;
    const size_t tstep = 2 * hstep;
    const unsigned ldsw = (unsigned)wid * 1024u;
    const int aoff = lds_byte(wr * 64 + fr, fq * 8), boff = lds_byte(wc * 32 + fr, fq * 8);
#define PG8_SA(b, h) (((b) * 2 + (h)) * HTB)
#define PG8_SB(b, h) ((4 + (b) * 2 + (h)) * HTB)
#define PG8_STAGE(bufoff, gbase, voff) do { _Pragma("unroll") for (int _i = 0; _i < 2; ++_i) \
        __builtin_amdgcn_global_load_lds((const unsigned*)((const char*)(gbase) + (voff)[_i]), (PG8_LAS unsigned*)(lds + (bufoff) + ldsw + _i * 8192), 16, 0, 0); } while (0)
#define PG8_LDA(dst, b, h) do { _Pragma("unroll") for (int m = 0; m < 4; ++m) _Pragma("unroll") for (int k = 0; k < 2; ++k) dst[m][k] = *(const PG8_LAS bf16x8*)(lds + PG8_SA(b, h) + aoff + m * 2048 + k * 1024); } while (0)
#define PG8_LDB(dst, b, h) do { _Pragma("unroll") for (int n = 0; n < 2; ++n) _Pragma("unroll") for (int k = 0; k < 2; ++k) dst[n][k] = *(const PG8_LAS bf16x8*)(lds + PG8_SB(b, h) + boff + n * 2048 + k * 1024); } while (0)
#define PG8_MMA(ai, bj, At, Bt) do { __builtin_amdgcn_s_setprio(1); _Pragma("unroll") for (int m = 0; m < 4; ++m) _Pragma("unroll") for (int n = 0; n < 2; ++n) _Pragma("unroll") for (int k = 0; k < 2; ++k) \
        acc[ai][bj][m][n] = __builtin_amdgcn_mfma_f32_16x16x32_bf16(Bt[n][k], At[m][k], acc[ai][bj][m][n], 0, 0, 0); __builtin_amdgcn_s_setprio(0); } while (0)
#define PG8_WAIT_V(n) asm volatile("s_waitcnt vmcnt(" #n ")" ::: "memory")
#define PG8_WAIT_L(n) asm volatile("s_waitcnt lgkmcnt(" #n ")" ::: "memory")
#define PG8_BAR __builtin_amdgcn_s_barrier()
#define PG8_SCHED __builtin_amdgcn_sched_barrier(0)
    Unit cur, nxt; int ui = 0;
    if (!S.next(0, cur)) return;
    f32x4 acc[2][2][4][2];
#pragma unroll
    for (int a = 0; a < 2; ++a)
#pragma unroll
        for (int b = 0; b < 2; ++b)
#pragma unroll
            for (int m = 0; m < 4; ++m)
#pragma unroll
                for (int n = 0; n < 2; ++n) acc[a][b][m][n] = (f32x4){0.f, 0.f, 0.f, 0.f};
    bf16x8 At[4][2], B0[2][2], B1[2][2];
    const char* cA = (const char*)g.A + (size_t)cur.pm * tstep; const char* cB = (const char*)g.Bt + (size_t)cur.pn * tstep;
    S.a_ready(cur);
    PG8_STAGE(PG8_SB(0, 0), cB, voffB); PG8_STAGE(PG8_SA(0, 0), cA, voffA); PG8_STAGE(PG8_SB(0, 1), cB + hstep, voffB); PG8_STAGE(PG8_SA(0, 1), cA + hstep, voffA);
    if (wr == 1) PG8_BAR;
    PG8_WAIT_V(4); PG8_BAR;
    PG8_STAGE(PG8_SB(1, 0), cB + kstep, voffB); PG8_STAGE(PG8_SA(1, 0), cA + kstep, voffA); PG8_STAGE(PG8_SB(1, 1), cB + hstep + kstep, voffB);
    PG8_WAIT_V(6); PG8_BAR;
    PG8_STAMP();
    for (;;) {
        const bool has_next = S.next(ui + 1, nxt);
        const char* nA = has_next ? (const char*)g.A + (size_t)nxt.pm * tstep : cA; const char* nB = has_next ? (const char*)g.Bt + (size_t)nxt.pn * tstep : cB;
        for (int t = 0; t < nt; t += 2) {
            const bool last = (t == nt - 2);
            const char* a1 = cA + (size_t)(t + 1) * kstep;
            const char* a2 = last ? nA : cA + (size_t)(t + 2) * kstep; const char* b2 = last ? nB : cB + (size_t)(t + 2) * kstep;
            const char* a3 = a2 + kstep; const char* b3 = b2 + kstep;
            if (last && has_next) S.a_ready(nxt);
            PG8_LDB(B0, 0, 0); PG8_SCHED; PG8_LDA(At, 0, 0); PG8_STAGE(PG8_SA(1, 1), a1 + hstep, voffA);
            PG8_WAIT_L(8); PG8_BAR; PG8_WAIT_L(0); PG8_MMA(0, 0, At, B0); PG8_BAR; PG8_SCHED;
            PG8_LDB(B1, 0, 1); PG8_STAGE(PG8_SB(0, 0), b2, voffB);
            PG8_BAR; PG8_WAIT_L(0); PG8_MMA(0, 1, At, B1); PG8_BAR;
            PG8_LDA(At, 0, 1); PG8_STAGE(PG8_SA(0, 0), a2, voffA);
            PG8_BAR; PG8_WAIT_L(0); PG8_MMA(1, 0, At, B0); PG8_BAR; PG8_SCHED;
            PG8_STAGE(PG8_SB(0, 1), b2 + hstep, voffB);
            PG8_WAIT_V(6); PG8_BAR; PG8_MMA(1, 1, At, B1); PG8_BAR;
            PG8_LDB(B0, 1, 0); PG8_SCHED; PG8_LDA(At, 1, 0); PG8_STAGE(PG8_SA(0, 1), a2 + hstep, voffA);
            PG8_WAIT_L(8); PG8_BAR; PG8_WAIT_L(0); PG8_MMA(0, 0, At, B0); PG8_BAR; PG8_SCHED;
            PG8_LDB(B1, 1, 1); PG8_STAGE(PG8_SB(1, 0), b3, voffB);
            PG8_BAR; PG8_WAIT_L(0); PG8_MMA(0, 1, At, B1); PG8_BAR;
            PG8_LDA(At, 1, 1); PG8_STAGE(PG8_SA(1, 0), a3, voffA);
            PG8_BAR; PG8_WAIT_L(0); PG8_MMA(1, 0, At, B0); PG8_BAR; PG8_SCHED;
            PG8_STAGE(PG8_SB(1, 1), b3 + hstep, voffB);
            PG8_WAIT_V(6); PG8_BAR; PG8_MMA(1, 1, At, B1); PG8_BAR;
        }
        PG8_STAMP();
        if constexpr (!Epi::AFTER_DRAIN) { E(acc, cur, wr, wc, fr, fq); S.done(cur); }
        PG8_STAMP();
        if (!has_next) break;
#pragma unroll
        for (int a = 0; a < 2; ++a)
#pragma unroll
            for (int b = 0; b < 2; ++b)
#pragma unroll
                for (int m = 0; m < 4; ++m)
#pragma unroll
                    for (int n = 0; n < 2; ++n) acc[a][b][m][n] = (f32x4){0.f, 0.f, 0.f, 0.f};
        cur = nxt; cA = nA; cB = nB; ++ui;
    }
    PG8_WAIT_V(0);
    if (wr == 0) PG8_BAR;
    PG8_BAR;
    if constexpr (Epi::AFTER_DRAIN) { E.fused(acc, cur, wr, wc, fr, fq, lds, wid, lane); S.done(cur); }
    PG8_STAMP();
    if (STAMP && wid == 0) { stamps[lane] = lane < nts ? (((unsigned long long)(unsigned)ts_hi << 32) | (unsigned)ts_lo) : 0ull;
        if (lane == 62) stamps[62] = rt_entry; if (lane == 63) stamps[63] = (unsigned long long)wall_clock64(); }
#undef PG8_STAMP
#undef PG8_SA
#undef PG8_SB
#undef PG8_STAGE
#undef PG8_LDA
#undef PG8_LDB
#undef PG8_MMA
#undef PG8_WAIT_V
#undef PG8_WAIT_L
#undef PG8_BAR
#undef PG8_SCHED
}
}

#define LAS __attribute__((address_space(3)))
#define XB_TMO      128
#define XB_XCNT(j)  (256  + 64 * (j))
#define XB_XSUB(j)  (1280 + 64 * (j))
#define XB_XGEN(j)  (2304 + 64 * (j))
#define XB_TOP      3328
#define XB_TOPGEN   3392
#define XCD_BAR_WORDS 3456
#define XB_SPIN_CAP (1u << 18)

__device__ __forceinline__ unsigned xb_ld(unsigned* p)              { return __hip_atomic_load(p, __ATOMIC_RELAXED, __HIP_MEMORY_SCOPE_AGENT); }
__device__ __forceinline__ unsigned xb_add(unsigned* p, unsigned v) { return __hip_atomic_fetch_add(p, v, __ATOMIC_RELAXED, __HIP_MEMORY_SCOPE_AGENT); }
__device__ __forceinline__ unsigned xb_xcc_id() { return (unsigned)__builtin_amdgcn_s_getreg((3 << 11) | 20) & 0xFu; }
#define XB_SPIN(cond, bar) do { unsigned _sp = 0; while (cond) { __builtin_amdgcn_s_sleep(1); \
    if ((++_sp & 255u) == 0u) { if (xb_ld(&(bar)[XB_TMO])) break; if (_sp > XB_SPIN_CAP) { atomicAdd(&(bar)[XB_TMO], 1u); break; } } } } while (0)

struct XcdBarrier {
    unsigned* bar; unsigned x;
    volatile LAS unsigned* st;
};

__device__ __forceinline__ XcdBarrier xcd_barrier_post(unsigned* bar, volatile LAS unsigned* st) {
    XcdBarrier b; b.bar = bar; b.x = xb_xcc_id(); b.st = st;
    if (threadIdx.x == 0) (void)xb_add(&bar[XB_XCNT(b.x)], 1u);
    return b;
}
__device__ __forceinline__ void xcd_barrier_complete(unsigned* bar, unsigned x, unsigned& nloc, unsigned& nx) {
    const unsigned G = gridDim.x * gridDim.y * gridDim.z;
    unsigned sum, cnt, mine, sp = 0u;
    for (;;) {
        sum = 0u; cnt = 0u; mine = 0u;
#pragma unroll
        for (unsigned j = 0; j < 16; ++j) { const unsigned c = xb_ld(&bar[XB_XCNT(j)]); sum += c; cnt += (c > 0u) ? 1u : 0u; mine = (j == x) ? c : mine; }
        if (sum == G) break;
        __builtin_amdgcn_s_sleep(1);
        if ((++sp & 255u) == 0u) { if (xb_ld(&bar[XB_TMO])) break; if (sp > XB_SPIN_CAP) { atomicAdd(&bar[XB_TMO], 1u); break; } }
    }
    nloc = mine > 0u ? mine : 1u; nx = cnt > 0u ? cnt : 1u;
}

__device__ __forceinline__ void xcd_barrier(const XcdBarrier& b) {
    asm volatile("s_waitcnt vmcnt(0)" ::: "memory");
    __syncthreads();
    if (threadIdx.x == 0) {
        unsigned* bar = b.bar;
        __builtin_amdgcn_s_waitcnt(0);
        unsigned nloc = b.st[0], nx = b.st[1];
        if (nloc == 0u) { xcd_barrier_complete(bar, b.x, nloc, nx); b.st[0] = nloc; b.st[1] = nx; }
        const unsigned old = xb_add(&bar[XB_XSUB(b.x)], 1u);
        const unsigned gen = old / nloc;
        if (old + 1u == (gen + 1u) * nloc) {
            __builtin_amdgcn_fence(__ATOMIC_RELEASE, "agent");
            asm volatile("s_waitcnt vmcnt(0)" ::: "memory");
            const unsigned og = xb_add(&bar[XB_TOP], 1u);
            const unsigned tg = og / nx;
            if (og + 1u == (tg + 1u) * nx) xb_add(&bar[XB_TOPGEN], 1u);
            else XB_SPIN(xb_ld(&bar[XB_TOPGEN]) == tg, bar);
            __builtin_amdgcn_fence(__ATOMIC_ACQUIRE, "agent");
            xb_add(&bar[XB_XGEN(b.x)], 1u);
            asm volatile("s_waitcnt vmcnt(0)" ::: "memory");
        } else {
            XB_SPIN(xb_ld(&bar[XB_XGEN(b.x)]) == gen, bar);
            __builtin_amdgcn_fence(__ATOMIC_ACQUIRE, "agent");
            asm volatile("s_waitcnt vmcnt(0)" ::: "memory");
        }
    }
    __syncthreads();
}
using namespace pg8;

typedef unsigned u32x2 __attribute__((ext_vector_type(2)));
typedef float f32x2v __attribute__((ext_vector_type(2)));

constexpr int DM = 2048, SEQ = 4096, NTOK_P = 8192, NTOK = 8224, M_PAD = 8448, NIN = 5632, DFF = 5632, PLE = 256;
constexpr int ZC_AQ = 0, ZC_AK = 1024, ZC_AV = 1280, ZC_RQ = 1536, ZC_RK = 2560, ZC_RV = 3584, ZC_RG = 4608;
constexpr float EPS = 1e-6f;
constexpr float ATTN_SCALE = 0.08838834764831845f, RET_K_SCALE = 0.08838834764831845f;
constexpr size_t O_YP = 0, O_YS = 16777216, O_KWP = 16842752, O_VWP = 16908288, O_RSP = 16973824, O_KWS = 17235968, O_VWS = 18284544, O_RSS = 19333120;
constexpr size_t W_IN = 0;
constexpr size_t W_OUT = W_IN + (size_t)NIN * DM * 2;
constexpr size_t W_GU = W_OUT + (size_t)DM * DM * 2;
constexpr size_t W_DOWN = W_GU + (size_t)2 * DFF * DM * 2;
constexpr size_t W_PLE = W_DOWN + (size_t)DM * DFF * 2;
constexpr size_t W_PG = W_PLE + (size_t)DM * PLE * 2;
constexpr size_t BUF_A = W_PG + (size_t)DM * DM * 2;
constexpr size_t BUF_B = BUF_A + (size_t)M_PAD * DM * 2;
constexpr size_t BUF_Z = BUF_B + (size_t)M_PAD * DM * 2;
constexpr size_t BUF_P = BUF_Z + (size_t)M_PAD * NIN * 2;
constexpr size_t BUF_RS = BUF_P + (size_t)M_PAD * PLE * 2;
constexpr size_t BUF_ROPE = BUF_RS + (size_t)2 * M_PAD * 4;
constexpr size_t BUF_BAR = ((BUF_ROPE + (size_t)2 * 4097 * 64 * 4 + 255) / 256) * 256;
constexpr size_t BUF_MIX = ((BUF_BAR + (size_t)XCD_BAR_WORDS * 4 + 255) / 256) * 256;
constexpr size_t BUF_XS = BUF_MIX + (size_t)M_PAD * DM * 2;
constexpr size_t WS_END = BUF_XS + (size_t)M_PAD * 4;
constexpr size_t BUF_KV16 = BUF_B;
constexpr size_t BUF_S16 = BUF_B + (size_t)512 * 16384 * 2;
constexpr int LDS_PHASE_BYTES = 141312, LDS_BYTES = LDS_PHASE_BYTES + 16;

struct Params {
  const float *x_p, *x_s, *ck, *cv, *st, *p_p, *p_s, *an, *w_in, *qn, *kn, *sinks, *rg, *w_out, *fn, *w_gate, *w_up, *w_down, *pn, *w_ple, *w_pg;
  float* out; unsigned char* ws; int never; int pad0;
};

__device__ __forceinline__ float bf_lo(unsigned w) { return __uint_as_float(w << 16); }
__device__ __forceinline__ float bf_hi(unsigned w) { return __uint_as_float(w & 0xffff0000u); }
__device__ __forceinline__ float bf2f(bf16_t v) { return __uint_as_float(((unsigned)v) << 16); }
__device__ __forceinline__ void unpack8(const u32x4 w, float (&f)[8]) {
  f[0] = bf_lo(w.x); f[1] = bf_hi(w.x); f[2] = bf_lo(w.y); f[3] = bf_hi(w.y); f[4] = bf_lo(w.z); f[5] = bf_hi(w.z); f[6] = bf_lo(w.w); f[7] = bf_hi(w.w);
}
__device__ __forceinline__ u32x4 pack8(const float (&f)[8]) {
  u32x4 w; w.x = cvt_pk_bf16(f[0], f[1]); w.y = cvt_pk_bf16(f[2], f[3]); w.z = cvt_pk_bf16(f[4], f[5]); w.w = cvt_pk_bf16(f[6], f[7]); return w;
}
__device__ __forceinline__ unsigned half_of(const u32x4 w, int e) { const unsigned x = (e >> 1) == 0 ? w.x : (e >> 1) == 1 ? w.y : (e >> 1) == 2 ? w.z : w.w; return (e & 1) ? (x >> 16) : (x & 0xffffu); }
__device__ __forceinline__ float sigmoid_f(float x) { return __builtin_amdgcn_rcpf(1.0f + __builtin_amdgcn_exp2f(x * -1.4426950408889634f)); }
__device__ __forceinline__ float silu_f(float x) { return x * sigmoid_f(x); }
__device__ __forceinline__ float wave_sum(float v) { for (int o = 32; o >= 1; o >>= 1) v += __shfl_xor(v, o); return v; }
__device__ __forceinline__ float wave_max(float v) { for (int o = 32; o >= 1; o >>= 1) v = fmaxf(v, __shfl_xor(v, o)); return v; }
__device__ __forceinline__ float ret_lg(int h) { return log1pf(-exp2f(-5.0f - (float)h)); }

struct EpiZ {
  static constexpr bool PERM = true, AFTER_DRAIN = false;
  bf16_t* O; int ldc;
  __device__ __forceinline__ void operator()(const f32x4 (&acc)[2][2][4][2], const Unit& u, int wr, int wc, int fr, int fq) const {
    const int row0 = u.pm * BM + wr * 64 + fr, col0 = u.pn * BM + wc * 32 + 8 * fq;
#pragma unroll
    for (int ai = 0; ai < 2; ++ai)
#pragma unroll
      for (int m = 0; m < 4; ++m) { bf16_t* rowp = O + (size_t)(row0 + ai * HALF + m * 16) * ldc + col0;
#pragma unroll
        for (int bj = 0; bj < 2; ++bj) { const f32x4 v0 = acc[ai][bj][m][0], v1 = acc[ai][bj][m][1];
          u32x4 w; w.x = cvt_pk_bf16(v0[0], v0[1]); w.y = cvt_pk_bf16(v0[2], v0[3]); w.z = cvt_pk_bf16(v1[0], v1[1]); w.w = cvt_pk_bf16(v1[2], v1[3]);
          *(u32x4*)(rowp + bj * HALF) = w; } }
  }
};
struct EpiRes3 {
  static constexpr bool PERM = true, AFTER_DRAIN = false;
  const bf16_t* A0; const float* xs; const float* an; bf16_t* HG; const float* g; float* rs;
  __device__ __forceinline__ void operator()(const f32x4 (&acc)[2][2][4][2], const Unit& u, int wr, int wc, int fr, int fq) const {
    const int row0 = u.pm * BM + wr * 64 + fr, col0 = u.pn * BM + wc * 32 + 8 * fq;
    float gi[2][8];
#pragma unroll
    for (int bj = 0; bj < 2; ++bj)
#pragma unroll
      for (int hf = 0; hf < 2; ++hf) { const f32x4 a = *(const f32x4*)(an + col0 + bj * HALF + hf * 4);
#pragma unroll
        for (int j = 0; j < 4; ++j) gi[bj][hf * 4 + j] = __builtin_amdgcn_rcpf(a[j]); }
#pragma unroll
    for (int ai = 0; ai < 2; ++ai) {
#pragma unroll
     for (int mb = 0; mb < 4; mb += 2) {
      u32x4 rr[4][2]; float xr[4];
#pragma unroll
      for (int m = mb; m < mb + 2; ++m) { xr[m] = xs[row0 + ai * HALF + m * 16];
#pragma unroll
        for (int bj = 0; bj < 2; ++bj) rr[m][bj] = *(const u32x4*)(A0 + (size_t)(row0 + ai * HALF + m * 16) * DM + col0 + bj * HALF); }
#pragma unroll
      for (int m = mb; m < mb + 2; ++m) {
        const int row = row0 + ai * HALF + m * 16; bf16_t* hp = HG + (size_t)row * DM + col0; float ss = 0.f;
#pragma unroll
        for (int bj = 0; bj < 2; ++bj) {
          float h[8]; unpack8(rr[m][bj], h);
#pragma unroll
          for (int j = 0; j < 8; ++j) { h[j] = h[j] * xr[m] * gi[bj][j] + acc[ai][bj][m][j >> 2][j & 3]; ss += h[j] * h[j]; }
          { const f32x4 o0 = *(const f32x4*)(g + col0 + bj * HALF), o1 = *(const f32x4*)(g + col0 + bj * HALF + 4);
#pragma unroll
            for (int j = 0; j < 8; ++j) h[j] *= (j < 4 ? o0[j & 3] : o1[j & 3]); }
          *(u32x4*)(hp + bj * HALF) = pack8(h); }
        ss += __shfl_xor(ss, 16); ss += __shfl_xor(ss, 32);
        if (fq == 0) atomicAdd(rs + row, ss);
      }
     }
    }
  }
};
struct EpiRes5 {
  static constexpr bool PERM = true, AFTER_DRAIN = false;
  const bf16_t* HGin; const float* gin; bf16_t* HGout; const float* gout; float* rs;
  __device__ __forceinline__ void operator()(const f32x4 (&acc)[2][2][4][2], const Unit& u, int wr, int wc, int fr, int fq) const {
    const int row0 = u.pm * BM + wr * 64 + fr, col0 = u.pn * BM + wc * 32 + 8 * fq;
    float gi[2][8];
#pragma unroll
    for (int bj = 0; bj < 2; ++bj)
#pragma unroll
      for (int hf = 0; hf < 2; ++hf) { const f32x4 a = *(const f32x4*)(gin + col0 + bj * HALF + hf * 4);
#pragma unroll
        for (int j = 0; j < 4; ++j) gi[bj][hf * 4 + j] = __builtin_amdgcn_rcpf(a[j]); }
#pragma unroll
    for (int ai = 0; ai < 2; ++ai) {
#pragma unroll
     for (int mb = 0; mb < 4; mb += 2) {
      u32x4 rr[4][2];
#pragma unroll
      for (int m = mb; m < mb + 2; ++m)
#pragma unroll
        for (int bj = 0; bj < 2; ++bj) rr[m][bj] = *(const u32x4*)(HGin + (size_t)(row0 + ai * HALF + m * 16) * DM + col0 + bj * HALF);
#pragma unroll
      for (int m = mb; m < mb + 2; ++m) {
        const int row = row0 + ai * HALF + m * 16; bf16_t* hp = HGout + (size_t)row * DM + col0; float ss = 0.f;
#pragma unroll
        for (int bj = 0; bj < 2; ++bj) {
          float h[8]; unpack8(rr[m][bj], h);
#pragma unroll
          for (int j = 0; j < 8; ++j) { h[j] = h[j] * gi[bj][j] + acc[ai][bj][m][j >> 2][j & 3]; ss += h[j] * h[j]; }
          { const f32x4 o0 = *(const f32x4*)(gout + col0 + bj * HALF), o1 = *(const f32x4*)(gout + col0 + bj * HALF + 4);
#pragma unroll
            for (int j = 0; j < 8; ++j) h[j] *= (j < 4 ? o0[j & 3] : o1[j & 3]); }
          *(u32x4*)(hp + bj * HALF) = pack8(h); }
        ss += __shfl_xor(ss, 16); ss += __shfl_xor(ss, 32);
        if (fq == 0) atomicAdd(rs + row, ss);
      }
     }
    }
  }
};
struct EpiAct {
  static constexpr bool PERM = true, AFTER_DRAIN = false;
  bf16_t* O; const float* rs;
  __device__ __forceinline__ void operator()(const f32x4 (&acc)[2][2][4][2], const Unit& u, int wr, int wc, int fr, int fq) const {
    const int row0 = u.pm * BM + wr * 64 + fr, col0 = u.pn * HALF + wc * 32 + 8 * fq;
#pragma unroll
    for (int ai = 0; ai < 2; ++ai)
#pragma unroll
      for (int m = 0; m < 4; ++m) {
        const int row = row0 + ai * HALF + m * 16;
        const float r = rsqrtf(rs[row] * (1.0f / DM) + EPS);
        float a[8];
#pragma unroll
        for (int n = 0; n < 2; ++n)
#pragma unroll
          for (int j = 0; j < 4; ++j) { const float gg = acc[ai][0][m][n][j] * r, uu = acc[ai][1][m][n][j] * r; a[n * 4 + j] = silu_f(gg) * uu; }
        *(u32x4*)(O + (size_t)row * DFF + col0) = pack8(a);
      }
  }
};
struct EpiPle {
  static constexpr bool PERM = true, AFTER_DRAIN = false;
  float* out; const bf16_t* HG; const float* g; const bf16_t* T; const float* rs;
  __device__ __forceinline__ void operator()(const f32x4 (&acc)[2][2][4][2], const Unit& u, int wr, int wc, int fr, int fq) const {
    const int row0 = u.pm * BM + wr * 64 + fr, col0 = u.pn * BM + wc * 32 + 8 * fq;
    float gi[2][8];
#pragma unroll
    for (int bj = 0; bj < 2; ++bj)
#pragma unroll
      for (int hf = 0; hf < 2; ++hf) { const f32x4 a = *(const f32x4*)(g + col0 + bj * HALF + hf * 4);
#pragma unroll
        for (int j = 0; j < 4; ++j) gi[bj][hf * 4 + j] = __builtin_amdgcn_rcpf(a[j]); }
#pragma unroll
    for (int ai = 0; ai < 2; ++ai) {
#pragma unroll
     for (int mb = 0; mb < 4; mb += 2) {
      u32x4 rh[4][2], rt[4][2]; float rr[4];
#pragma unroll
      for (int m = mb; m < mb + 2; ++m) { const int row = row0 + ai * HALF + m * 16; rr[m] = rs[row];
#pragma unroll
        for (int bj = 0; bj < 2; ++bj) { rh[m][bj] = *(const u32x4*)(HG + (size_t)row * DM + col0 + bj * HALF); rt[m][bj] = *(const u32x4*)(T + (size_t)row * DM + col0 + bj * HALF); } }
#pragma unroll
      for (int m = mb; m < mb + 2; ++m) {
        const int row = row0 + ai * HALF + m * 16; const float r = rsqrtf(rr[m] * (1.0f / DM) + EPS); float* op = out + (size_t)row * DM + col0;
#pragma unroll
        for (int bj = 0; bj < 2; ++bj) {
          float h[8], t[8]; unpack8(rh[m][bj], h); unpack8(rt[m][bj], t);
#pragma unroll
          for (int j = 0; j < 8; ++j) h[j] = h[j] * gi[bj][j] + t[j] * sigmoid_f(acc[ai][bj][m][j >> 2][j & 3] * r);
          *(f32x4*)(op + bj * HALF) = (f32x4){h[0], h[1], h[2], h[3]}; *(f32x4*)(op + bj * HALF + 4) = (f32x4){h[4], h[5], h[6], h[7]}; }
      }
     }
    }
  }
};
struct TDesc { const float* src; bf16_t* dst; int K, N, rs, off, t; };
constexpr int TT_IN = (DM / 128) * (NIN / 64), TT_OUT = (DM / 128) * (DM / 64), TT_G = (DM / 128) * (DFF / 64), TT_D = (DFF / 128) * (DM / 64), TT_PL = (PLE / 128) * (DM / 64), TT_PG = TT_OUT;
template <int LIST> __device__ __forceinline__ int tjobs() { return LIST == 0 ? TT_IN + 2 * TT_G + TT_OUT + TT_PG + TT_PL : LIST == 1 ? 0 : TT_D; }
template <int LIST> __device__ __forceinline__ TDesc tdesc(const Params& p, int g) {
  unsigned char* ws = p.ws; TDesc d;
  if (LIST == 0) {
    if (g < TT_IN) d = TDesc{p.w_in, (bf16_t*)(ws + W_IN), DM, NIN, 128, 0, g};
    else if (g < TT_IN + TT_G) d = TDesc{p.w_gate, (bf16_t*)(ws + W_GU), DM, DFF, 256, 0, g - TT_IN};
    else if (g < TT_IN + 2 * TT_G) d = TDesc{p.w_up, (bf16_t*)(ws + W_GU), DM, DFF, 256, 128, g - TT_IN - TT_G};
    else if (g < TT_IN + 2 * TT_G + TT_OUT) d = TDesc{p.w_out, (bf16_t*)(ws + W_OUT), DM, DM, 128, 0, g - TT_IN - 2 * TT_G};
    else if (g < TT_IN + 2 * TT_G + TT_OUT + TT_PG) d = TDesc{p.w_pg, (bf16_t*)(ws + W_PG), DM, DM, 128, 0, g - TT_IN - 2 * TT_G - TT_OUT};
    else d = TDesc{p.w_ple, (bf16_t*)(ws + W_PLE), PLE, DM, 128, 0, g - TT_IN - 2 * TT_G - TT_OUT - TT_PG};
  } else if (LIST == 1) d = TDesc{p.w_out, (bf16_t*)(ws + W_OUT), DM, DM, 128, 0, g};
  else {
    d = TDesc{p.w_down, (bf16_t*)(ws + W_DOWN), DFF, DM, 128, 0, g};
  }
  return d;
}
template <int LIST> __device__ __forceinline__ void tload4(const Params& p, int g0, int step, f32x4 (&v)[4][4]) {
  const int tid = opaque_tid(), njobs = tjobs<LIST>();
#pragma unroll
  for (int u = 0; u < 4; ++u) { const int g = g0 + u * step;
    if (g < njobs) { const TDesc d = tdesc<LIST>(p, g); const int nnt = d.N >> 7, k0 = (d.t / nnt) * 64, n0 = (d.t % nnt) * 128;
#pragma unroll
      for (int i = 0; i < 4; ++i) v[u][i] = __builtin_nontemporal_load((const f32x4*)(d.src + (size_t)(k0 + (tid >> 5) + 16 * i) * d.N + n0 + (tid & 31) * 4)); } }
}
template <int LIST> __device__ __forceinline__ void transpose_jobs(const Params& p, LAS unsigned char* lds, int first, int step) {
  const int tid = opaque_tid(), njobs = tjobs<LIST>();
  if (first >= njobs) return;
  f32x4 v[4][4], vn[4][4];
  tload4<LIST>(p, first, step, v);
  for (int g0 = first; g0 < njobs; g0 += 4 * step) {
    const bool more = g0 + 4 * step < njobs;
    if (more) tload4<LIST>(p, g0 + 4 * step, step, vn);
#pragma unroll
    for (int u = 0; u < 4; ++u) { if (g0 + u * step < njobs) { LAS float* tile = (LAS float*)lds + u * (64 * 129);
#pragma unroll
        for (int i = 0; i < 4; ++i) { LAS float* q = tile + ((tid >> 5) + 16 * i) * 129 + (tid & 31) * 4; q[0] = v[u][i][0]; q[1] = v[u][i][1]; q[2] = v[u][i][2]; q[3] = v[u][i][3]; } } }
    __syncthreads();
#pragma unroll
    for (int u = 0; u < 4; ++u) { const int g = g0 + u * step;
      if (g < njobs) { const TDesc d = tdesc<LIST>(p, g); const int nnt = d.N >> 7, k0 = (d.t / nnt) * 64, n0 = (d.t % nnt) * 128;
        const LAS float* tile = (const LAS float*)lds + u * (64 * 129);
        const int n = tid >> 2, kb = (tid & 3) * 16; float f[16];
#pragma unroll
        for (int j = 0; j < 16; ++j) f[j] = tile[(kb + j) * 129 + n];
        const int nn = n0 + n, drow = (nn >> 7) * d.rs + (nn & 127) + d.off;
        bf16_t* dp = d.dst + (size_t)drow * d.K + k0 + kb;
        u32x4 w0, w1;
        w0.x = cvt_pk_bf16(f[0], f[1]); w0.y = cvt_pk_bf16(f[2], f[3]); w0.z = cvt_pk_bf16(f[4], f[5]); w0.w = cvt_pk_bf16(f[6], f[7]);
        w1.x = cvt_pk_bf16(f[8], f[9]); w1.y = cvt_pk_bf16(f[10], f[11]); w1.z = cvt_pk_bf16(f[12], f[13]); w1.w = cvt_pk_bf16(f[14], f[15]);
        *(u32x4*)dp = w0; *(u32x4*)(dp + 8) = w1; } }
    __syncthreads();
    if (more) {
#pragma unroll
      for (int u = 0; u < 4; ++u)
#pragma unroll
        for (int i = 0; i < 4; ++i) v[u][i] = vn[u][i]; }
  }
}

__device__ __forceinline__ void phase_prep(const Params& p, LAS unsigned char* lds) {
  const int tid = opaque_tid(), wid = __builtin_amdgcn_readfirstlane(tid >> 6), lane = tid & 63;
  unsigned char* ws = p.ws;
  {
    bf16_t* A0 = (bf16_t*)(ws + BUF_A);
    for (int row = blockIdx.x * 8 + wid; row < M_PAD; row += gridDim.x * 8) {
      bf16_t* dst = A0 + (size_t)row * DM;
      if (row >= NTOK) {
#pragma unroll
        for (int i = 0; i < 8; ++i) *(u32x2*)(dst + (i * 64 + lane) * 4) = (u32x2){0u, 0u};
        continue;
      }
      const float* src = row < NTOK_P ? p.x_p + (size_t)row * DM : p.x_s + (size_t)(row - NTOK_P) * DM;
      f32x4 v[8]; float ss = 0.f;
#pragma unroll
      for (int i = 0; i < 8; ++i) { v[i] = __builtin_nontemporal_load((const f32x4*)(src + (i * 64 + lane) * 4)); ss += v[i][0] * v[i][0] + v[i][1] * v[i][1] + v[i][2] * v[i][2] + v[i][3] * v[i][3]; }
      ss = wave_sum(ss);
      const float r = rsqrtf(ss * (1.0f / DM) + EPS);
      if (lane == 0) ((float*)(ws + BUF_XS))[row] = sqrtf(ss * (1.0f / DM) + EPS);
#pragma unroll
      for (int i = 0; i < 8; ++i) { const f32x4 g = *(const f32x4*)(p.an + (i * 64 + lane) * 4); const f32x4 y = v[i] * r * g;
        *(u32x2*)(dst + (i * 64 + lane) * 4) = (u32x2){cvt_pk_bf16(y[0], y[1]), cvt_pk_bf16(y[2], y[3])}; }
    }
  }
  transpose_jobs<0>(p, lds, blockIdx.x, gridDim.x);
  const size_t gtid = (size_t)blockIdx.x * 512 + tid, gstride = (size_t)gridDim.x * 512;
  {
    bf16_t* P = (bf16_t*)(ws + BUF_P);
    for (size_t i = gtid; i < (size_t)M_PAD * 64; i += gstride) {
      const int row = (int)(i >> 6), c4 = (int)(i & 63) * 4;
      f32x4 v = (f32x4){0.f, 0.f, 0.f, 0.f};
      if (row < NTOK_P) v = *(const f32x4*)(p.p_p + (size_t)row * PLE + c4); else if (row < NTOK) v = *(const f32x4*)(p.p_s + (size_t)(row - NTOK_P) * PLE + c4);
      *(u32x2*)(P + (size_t)row * PLE + c4) = (u32x2){cvt_pk_bf16(v[0], v[1]), cvt_pk_bf16(v[2], v[3])};
    }
  }
  { float* rs = (float*)(ws + BUF_RS); for (size_t i = gtid; i < (size_t)2 * M_PAD; i += gstride) rs[i] = 0.f; }
  {
    float* rc = (float*)(ws + BUF_ROPE); float* rsn = rc + 4097 * 64;
    for (size_t i = gtid; i < (size_t)4097 * 64; i += gstride) {
      const int e = (int)(i >> 6), j = (int)(i & 63);
      const float pos = e < 4096 ? (float)e : 16384.0f;
      const float inv = (float)exp2(-(double)j * (13.287712379549449 / 64.0));
      const float ang = pos * inv;
      const double rev = (double)ang * 0.15915494309189535; const float fr = (float)(rev - floor(rev));
      rc[i] = __builtin_amdgcn_cosf(fr); rsn[i] = __builtin_amdgcn_sinf(fr);
    }
  }
}

#define MFMA16(a, b, c) __builtin_amdgcn_mfma_f32_16x16x32_bf16((a), (b), (c), 0, 0, 0)
constexpr int LDR = 272;
__device__ __forceinline__ void wave_store_rows16(const LAS unsigned char* buf, int rs, bf16_t* g, size_t grs, int lane) {
#pragma unroll
  for (int i = 0; i < 4; ++i) { const int row = (lane >> 4) + 4 * i, ch = lane & 15; *(u32x4*)(g + (size_t)row * grs + ch * 8) = *(const LAS u32x4*)(buf + row * rs + ch * 16); }
}

__device__ __forceinline__ void rot16(const bf16_t* zrow, int cc, const float* rc, const float* rsn, int pos_entry, float sc, float (&o1)[8], float (&o2)[8]) {
  float x1[8], x2[8]; unpack8(*(const u32x4*)(zrow + cc * 8), x1); unpack8(*(const u32x4*)(zrow + 64 + cc * 8), x2);
  const f32x4 c0 = *(const f32x4*)(rc + pos_entry * 64 + cc * 8), c1 = *(const f32x4*)(rc + pos_entry * 64 + cc * 8 + 4);
  const f32x4 s0 = *(const f32x4*)(rsn + pos_entry * 64 + cc * 8), s1 = *(const f32x4*)(rsn + pos_entry * 64 + cc * 8 + 4);
#pragma unroll
  for (int e = 0; e < 8; ++e) { const float cs = e < 4 ? c0[e & 3] : c1[e & 3], sn = e < 4 ? s0[e & 3] : s1[e & 3];
    o1[e] = (x1[e] * cs - x2[e] * sn) * sc; o2[e] = (x1[e] * sn + x2[e] * cs) * sc; }
}

__device__ __forceinline__ void attn_item(const Params& p, LAS unsigned char* lds, int item) {
  constexpr int K_OFF = 0, V_OFF = 256 * LDR, VLD = 560, PLD = 336, PWAVE = 16 * PLD;
  const int tid = opaque_tid(), wid = __builtin_amdgcn_readfirstlane(tid >> 6), lane = tid & 63, fr = lane & 15, fq = lane >> 4;
  int b, blk, h;
  if (gridDim.x == 256) { const int r = item >> 8, cidx = item & 255, x = cidx & 7, y = cidx >> 3, s = r * 8 + x;
    b = s & 1; h = ((s >> 1) & 1) * 4 + (y & 3); blk = (s >> 2) * 8 + (y >> 2); }
  else { b = item >> 8; blk = (item >> 3) & 31; h = item & 7; }
  const int kvh = h >> 2;
  const bf16_t* Z = (const bf16_t*)(p.ws + BUF_Z);
  bf16_t* MIX = (bf16_t*)(p.ws + BUF_MIX);
  const int tok0 = b * SEQ + blk * 128;
  bf16x8 Qa[4];
  {
    const bf16_t* qp = Z + (size_t)(tok0 + wid * 16 + fr) * NIN + ZC_AQ + h * 128 + fq * 8;
    float qf[4][8]; float ss = 0.f;
#pragma unroll
    for (int ks = 0; ks < 4; ++ks) { unpack8(*(const u32x4*)(qp + ks * 32), qf[ks]);
#pragma unroll
      for (int e = 0; e < 8; ++e) ss += qf[ks][e] * qf[ks][e]; }
    ss += __shfl_xor(ss, 16); ss += __shfl_xor(ss, 32);
    const float r = rsqrtf(ss * (1.0f / 128.0f) + EPS);
#pragma unroll
    for (int ks = 0; ks < 4; ++ks) { const f32x4 g0 = *(const f32x4*)(p.qn + ks * 32 + fq * 8), g1 = *(const f32x4*)(p.qn + ks * 32 + fq * 8 + 4);
      float y[8];
#pragma unroll
      for (int e = 0; e < 8; ++e) y[e] = qf[ks][e] * r * (e < 4 ? g0[e & 3] : g1[e & 3]);
      const u32x4 w = pack8(y); Qa[ks] = *(const bf16x8*)&w; }
  }
  const bool write_win = (blk == 31) && ((h & 3) == 0);
  {
    const int c = tid & 15; const f32x4 g0 = *(const f32x4*)(p.kn + c * 8), g1 = *(const f32x4*)(p.kn + c * 8 + 4);
#pragma unroll
    for (int i = 0; i < 8; ++i) {
      const int row = (tid >> 4) + 32 * i, kpos = (blk - 1) * 128 + row;
      u32x4 raw = (u32x4){0u, 0u, 0u, 0u};
      if (kpos >= 0) raw = *(const u32x4*)(Z + (size_t)(b * SEQ + kpos) * NIN + ZC_AK + kvh * 128 + c * 8);
      float f[8]; unpack8(raw, f); float ss = 0.f;
#pragma unroll
      for (int e = 0; e < 8; ++e) ss += f[e] * f[e];
      ss += __shfl_xor(ss, 1); ss += __shfl_xor(ss, 2); ss += __shfl_xor(ss, 4); ss += __shfl_xor(ss, 8);
      const float r = rsqrtf(ss * (1.0f / 128.0f) + EPS);
#pragma unroll
      for (int e = 0; e < 8; ++e) f[e] = f[e] * r * (e < 4 ? g0[e & 3] : g1[e & 3]);
      *(LAS u32x4*)(lds + K_OFF + row * LDR + c * 16) = pack8(f);
      if (write_win && row >= 128) { float* kw = p.out + O_KWP + ((size_t)(b * 128 + row - 128) * 2 + kvh) * 128 + c * 8;
        *(f32x4*)kw = (f32x4){f[0], f[1], f[2], f[3]}; *(f32x4*)(kw + 4) = (f32x4){f[4], f[5], f[6], f[7]}; }
    }
  }
  {
    const int c = tid & 15;
#pragma unroll
    for (int i = 0; i < 4; ++i) {
      const int kp = (tid >> 4) + 32 * i, j0 = 2 * kp, kpos = (blk - 1) * 128 + j0;
      u32x4 r0 = (u32x4){0u, 0u, 0u, 0u}, r1 = r0;
      if (kpos >= 0) { const bf16_t* vp = Z + (size_t)(b * SEQ + kpos) * NIN + ZC_AV + kvh * 128 + c * 8; r0 = *(const u32x4*)vp; r1 = *(const u32x4*)(vp + NIN); }
#pragma unroll
      for (int e = 0; e < 8; ++e) *(LAS unsigned*)(lds + V_OFF + (c * 8 + e) * VLD + (kp ^ (c << 2)) * 4) = half_of(r0, e) | (half_of(r1, e) << 16);
      if (write_win && j0 >= 128) { float f0[8], f1[8]; unpack8(r0, f0); unpack8(r1, f1);
        float* vw = p.out + O_VWP + ((size_t)(b * 128 + j0 - 128) * 2 + kvh) * 128 + c * 8;
        *(f32x4*)vw = (f32x4){f0[0], f0[1], f0[2], f0[3]}; *(f32x4*)(vw + 4) = (f32x4){f0[4], f0[5], f0[6], f0[7]};
        *(f32x4*)(vw + 256) = (f32x4){f1[0], f1[1], f1[2], f1[3]}; *(f32x4*)(vw + 260) = (f32x4){f1[4], f1[5], f1[6], f1[7]}; }
    }
    if (tid < 256) *(LAS u32x4*)(lds + V_OFF + (tid >> 1) * VLD + 512 + (tid & 1) * 16) = (u32x4){0u, 0u, 0u, 0u};
  }
  __syncthreads();
  f32x4 S[9];
#pragma unroll
  for (int tt = 0; tt < 9; ++tt) S[tt] = (f32x4){0.f, 0.f, 0.f, 0.f};
#pragma unroll
  for (int ks = 0; ks < 4; ++ks)
#pragma unroll
    for (int tt = 0; tt < 9; ++tt) { const bf16x8 kb = *(const LAS bf16x8*)(lds + K_OFF + ((wid + tt) * 16 + fr) * LDR + (ks * 32 + fq * 8) * 2); S[tt] = MFMA16(kb, Qa[ks], S[tt]); }
  const int qi = wid * 16 + fr; const float sink = p.sinks[h];
  float mx = sink;
#pragma unroll
  for (int tt = 0; tt < 9; ++tt)
#pragma unroll
    for (int jj = 0; jj < 4; ++jj) { const int j = (wid + tt) * 16 + fq * 4 + jj; const bool valid = (j >= qi) && (j <= qi + 128) && (blk > 0 || j >= 128);
      const float s = valid ? S[tt][jj] * ATTN_SCALE : -INFINITY; S[tt][jj] = s; mx = fmaxf(mx, s); }
  mx = fmaxf(mx, __shfl_xor(mx, 16)); mx = fmaxf(mx, __shfl_xor(mx, 32));
  float sum = 0.f;
#pragma unroll
  for (int tt = 0; tt < 9; ++tt)
#pragma unroll
    for (int jj = 0; jj < 4; ++jj) { const float e = __expf(S[tt][jj] - mx); S[tt][jj] = e; sum += e; }
  sum += __shfl_xor(sum, 16); sum += __shfl_xor(sum, 32);
  const float inv = 1.0f / (sum + __expf(sink - mx));
  __syncthreads();
  LAS unsigned char* Pw = lds + K_OFF + wid * PWAVE;
#pragma unroll
  for (int tt = 0; tt < 9; ++tt) *(LAS u32x2*)(Pw + fr * PLD + (tt * 16 + fq * 4) * 2) = (u32x2){cvt_pk_bf16(S[tt][0] * inv, S[tt][1] * inv), cvt_pk_bf16(S[tt][2] * inv, S[tt][3] * inv)};
  *(LAS u32x2*)(Pw + fr * PLD + (9 * 16 + fq * 4) * 2) = (u32x2){0u, 0u};
  __syncthreads();
  f32x4 O[8];
#pragma unroll
  for (int nt = 0; nt < 8; ++nt) O[nt] = (f32x4){0.f, 0.f, 0.f, 0.f};
#pragma unroll
  for (int ks = 0; ks < 5; ++ks) { const bf16x8 pa = *(const LAS bf16x8*)(Pw + fr * PLD + (ks * 32 + fq * 8) * 2);
#pragma unroll
    for (int nt = 0; nt < 8; ++nt) { const int kp0 = wid * 8 + ks * 16 + fq * 4, kps = kp0 < 128 ? (kp0 ^ ((nt * 2 + (fr >> 3)) << 2)) : kp0;
      const bf16x8 vb = *(const LAS bf16x8*)(lds + V_OFF + (nt * 16 + fr) * VLD + kps * 4); O[nt] = MFMA16(vb, pa, O[nt]); } }
#pragma unroll
  for (int nt = 0; nt < 8; ++nt) *(LAS u32x2*)(Pw + fr * PLD + (nt * 16 + fq * 4) * 2) = (u32x2){cvt_pk_bf16(O[nt][0], O[nt][1]), cvt_pk_bf16(O[nt][2], O[nt][3])};
  wave_store_rows16(Pw, PLD, MIX + (size_t)(tok0 + wid * 16) * DM + h * 128, DM, lane);
  __syncthreads();
}

__device__ __forceinline__ void stage_vt128(const bf16_t* Z, int tok0, int col, LAS unsigned char* dst) {
  const int tid = opaque_tid(), c = tid & 15;
#pragma unroll
  for (int i = 0; i < 2; ++i) { const int kp = (tid >> 4) + 32 * i; const bf16_t* vp = Z + (size_t)(tok0 + 2 * kp) * NIN + col + c * 8;
    const u32x4 r0 = *(const u32x4*)vp, r1 = *(const u32x4*)(vp + NIN);
#pragma unroll
    for (int e = 0; e < 8; ++e) *(LAS unsigned*)(dst + (c * 8 + e) * LDR + (kp ^ (c << 2)) * 4) = half_of(r0, e) | (half_of(r1, e) << 16); }
}
__device__ __forceinline__ void retkv_item(const Params& p, LAS unsigned char* lds, int item) {
  constexpr int KT_OFF = 0, VT_OFF = 128 * LDR;
  const int tid = opaque_tid(), wid = __builtin_amdgcn_readfirstlane(tid >> 6), lane = tid & 63, fr = lane & 15, fq = lane >> 4;
  const int bh = item >> 5, c = item & 31, b = bh >> 3, h = bh & 7;
  const bf16_t* Z = (const bf16_t*)(p.ws + BUF_Z);
  const float* rc = (const float*)(p.ws + BUF_ROPE); const float* rsn = rc + 4097 * 64;
  bf16_t* KV = (bf16_t*)(p.ws + BUF_KV16);
  const int tok0 = b * SEQ + c * 128; const float lg = ret_lg(h);
  {
    const int cc = tid & 7, kp = tid >> 3, n0 = 2 * kp;
    float a1[8], a2[8], b1[8], b2[8];
    rot16(Z + (size_t)(tok0 + n0) * NIN + ZC_RK + h * 128, cc, rc, rsn, c * 128 + n0, RET_K_SCALE * __expf(lg * (float)(127 - n0)), a1, a2);
    rot16(Z + (size_t)(tok0 + n0 + 1) * NIN + ZC_RK + h * 128, cc, rc, rsn, c * 128 + n0 + 1, RET_K_SCALE * __expf(lg * (float)(126 - n0)), b1, b2);
#pragma unroll
    for (int e = 0; e < 8; ++e) { *(LAS unsigned*)(lds + KT_OFF + (cc * 8 + e) * LDR + (kp ^ (cc << 3)) * 4) = cvt_pk_bf16(a1[e], b1[e]);
      *(LAS unsigned*)(lds + KT_OFF + (64 + cc * 8 + e) * LDR + (kp ^ (cc << 3)) * 4) = cvt_pk_bf16(a2[e], b2[e]); }
  }
  stage_vt128(Z, tok0, ZC_RV + h * 128, lds + VT_OFF);
  __syncthreads();
  f32x4 acc[8];
#pragma unroll
  for (int nt = 0; nt < 8; ++nt) acc[nt] = (f32x4){0.f, 0.f, 0.f, 0.f};
#pragma unroll
  for (int ks = 0; ks < 4; ++ks) { const int kp0 = ks * 16 + fq * 4;
    const bf16x8 a = *(const LAS bf16x8*)(lds + KT_OFF + (wid * 16 + fr) * LDR + (kp0 ^ (((wid * 2 + (fr >> 3)) & 7) << 3)) * 4);
#pragma unroll
    for (int nt = 0; nt < 8; ++nt) { const bf16x8 vb = *(const LAS bf16x8*)(lds + VT_OFF + (nt * 16 + fr) * LDR + (kp0 ^ ((nt * 2 + (fr >> 3)) << 2)) * 4); acc[nt] = MFMA16(vb, a, acc[nt]); } }
  LAS unsigned char* wb = lds + KT_OFF + (wid * 16) * LDR;
#pragma unroll
  for (int nt = 0; nt < 8; ++nt) *(LAS u32x2*)(wb + fr * LDR + (nt * 16 + fq * 4) * 2) = (u32x2){cvt_pk_bf16(acc[nt][0], acc[nt][1]), cvt_pk_bf16(acc[nt][2], acc[nt][3])};
  wave_store_rows16(wb, LDR, KV + (size_t)item * 16384 + (wid * 16) * 128, 128, lane);
  __syncthreads();
}

__device__ __forceinline__ void phase_scan(const Params& p) {
  const u32x2* KV = (const u32x2*)(p.ws + BUF_KV16);
  const size_t gtid = (size_t)blockIdx.x * 512 + threadIdx.x, gstride = (size_t)gridDim.x * 512;
  for (size_t idx = gtid; idx < (size_t)16 * 4096; idx += gstride) {
    const int bh = (int)(idx >> 12), e4 = (int)(idx & 4095), h = bh & 7;
    const float dec = __expf(ret_lg(h) * 128.0f);
    const u32x2* base = KV + (size_t)bh * 32 * 4096 + e4; u32x2* s16 = (u32x2*)(p.ws + BUF_S16) + (size_t)bh * 32 * 4096 + e4;
    u32x2 v[32];
#pragma unroll
    for (int c = 0; c < 32; ++c) v[c] = base[(size_t)c * 4096];
    f32x4 s = (f32x4){0.f, 0.f, 0.f, 0.f};
#pragma unroll
    for (int c = 0; c < 32; ++c) { s16[(size_t)c * 4096] = (u32x2){cvt_pk_bf16(s[0], s[1]), cvt_pk_bf16(s[2], s[3])};
      s = s * dec + (f32x4){bf_lo(v[c].x), bf_hi(v[c].x), bf_lo(v[c].y), bf_hi(v[c].y)}; }
    *(f32x4*)(p.out + O_RSP + (size_t)bh * 16384 + e4 * 4) = s;
  }
}

__device__ __forceinline__ void retout_item(const Params& p, LAS unsigned char* lds, int item) {
  constexpr int Q_OFF = 0, K_OFF = 128 * LDR, VT_OFF = 256 * LDR, ST_OFF = 384 * LDR;
  const int tid = opaque_tid(), wid = __builtin_amdgcn_readfirstlane(tid >> 6), lane = tid & 63, fr = lane & 15, fq = lane >> 4;
  const int bh = item >> 5, c = item & 31, b = bh >> 3, h = bh & 7;
  const bf16_t* Z = (const bf16_t*)(p.ws + BUF_Z);
  bf16_t* MIX = (bf16_t*)(p.ws + BUF_MIX);
  const float* rc = (const float*)(p.ws + BUF_ROPE); const float* rsn = rc + 4097 * 64;
  const bf16_t* SP = (const bf16_t*)(p.ws + BUF_S16) + (size_t)item * 16384;
  const int tok0 = b * SEQ + c * 128; const float lg = ret_lg(h);
  {
    const int cc = tid & 7;
#pragma unroll
    for (int i = 0; i < 2; ++i) { const int n = (tid >> 3) + 64 * i; float o1[8], o2[8];
      rot16(Z + (size_t)(tok0 + n) * NIN + ZC_RQ + h * 128, cc, rc, rsn, c * 128 + n, 1.0f, o1, o2);
      *(LAS u32x4*)(lds + Q_OFF + n * LDR + cc * 16) = pack8(o1); *(LAS u32x4*)(lds + Q_OFF + n * LDR + (cc + 8) * 16) = pack8(o2);
      rot16(Z + (size_t)(tok0 + n) * NIN + ZC_RK + h * 128, cc, rc, rsn, c * 128 + n, RET_K_SCALE, o1, o2);
      *(LAS u32x4*)(lds + K_OFF + n * LDR + cc * 16) = pack8(o1); *(LAS u32x4*)(lds + K_OFF + n * LDR + (cc + 8) * 16) = pack8(o2); }
  }
  stage_vt128(Z, tok0, ZC_RV + h * 128, lds + VT_OFF);
  {
    const int c16 = tid & 15;
#pragma unroll
    for (int i = 0; i < 2; ++i) { const int kp = (tid >> 4) + 32 * i; const bf16_t* sp = SP + (size_t)(2 * kp) * 128 + c16 * 8;
      const u32x4 r0 = *(const u32x4*)sp, r1 = *(const u32x4*)(sp + 128);
#pragma unroll
      for (int e = 0; e < 8; ++e) *(LAS unsigned*)(lds + ST_OFF + (c16 * 8 + e) * LDR + (kp ^ (c16 << 2)) * 4) = half_of(r0, e) | (half_of(r1, e) << 16); }
  }
  __syncthreads();
  const int n = wid * 16 + fr;
  bf16x8 Qa[4];
#pragma unroll
  for (int ks = 0; ks < 4; ++ks) Qa[ks] = *(const LAS bf16x8*)(lds + Q_OFF + n * LDR + (ks * 32 + fq * 8) * 2);
  f32x4 O[8];
#pragma unroll
  for (int nt = 0; nt < 8; ++nt) O[nt] = (f32x4){0.f, 0.f, 0.f, 0.f};
#pragma unroll
  for (int ks = 0; ks < 4; ++ks)
#pragma unroll
    for (int nt = 0; nt < 8; ++nt) { const bf16x8 sb = *(const LAS bf16x8*)(lds + ST_OFF + (nt * 16 + fr) * LDR + ((ks * 16 + fq * 4) ^ ((nt * 2 + (fr >> 3)) << 2)) * 4); O[nt] = MFMA16(sb, Qa[ks], O[nt]); }
  const float qdec = __expf(lg * (float)(n + 1));
#pragma unroll
  for (int nt = 0; nt < 8; ++nt) O[nt] *= qdec;
  f32x4 SC[8];
#pragma unroll
  for (int tt = 0; tt < 8; ++tt) { SC[tt] = (f32x4){0.f, 0.f, 0.f, 0.f};
    if (tt <= wid) {
#pragma unroll
      for (int ks = 0; ks < 4; ++ks) { const bf16x8 kb = *(const LAS bf16x8*)(lds + K_OFF + (tt * 16 + fr) * LDR + (ks * 32 + fq * 8) * 2); SC[tt] = MFMA16(kb, Qa[ks], SC[tt]); } } }
  __syncthreads();
#pragma unroll
  for (int tt = 0; tt < 8; ++tt) { float pv[4];
#pragma unroll
    for (int jj = 0; jj < 4; ++jj) { const int e = tt * 16 + fq * 4 + jj; pv[jj] = (e <= n) ? SC[tt][jj] * __expf(lg * (float)(n - e)) : 0.f; }
    *(LAS u32x2*)(lds + K_OFF + n * LDR + (tt * 16 + fq * 4) * 2) = (u32x2){cvt_pk_bf16(pv[0], pv[1]), cvt_pk_bf16(pv[2], pv[3])}; }
  __syncthreads();
#pragma unroll
  for (int ks = 0; ks < 4; ++ks) { const bf16x8 pa = *(const LAS bf16x8*)(lds + K_OFF + n * LDR + (ks * 32 + fq * 8) * 2);
#pragma unroll
    for (int nt = 0; nt < 8; ++nt) { const bf16x8 vb = *(const LAS bf16x8*)(lds + VT_OFF + (nt * 16 + fr) * LDR + ((ks * 16 + fq * 4) ^ ((nt * 2 + (fr >> 3)) << 2)) * 4); O[nt] = MFMA16(vb, pa, O[nt]); } }
  float ss = 0.f;
#pragma unroll
  for (int nt = 0; nt < 8; ++nt) ss += O[nt][0] * O[nt][0] + O[nt][1] * O[nt][1] + O[nt][2] * O[nt][2] + O[nt][3] * O[nt][3];
  ss += __shfl_xor(ss, 16); ss += __shfl_xor(ss, 32);
  const float r = rsqrtf(ss * (1.0f / 128.0f) + EPS);
  LAS unsigned char* wb = lds + K_OFF + (wid * 16) * LDR;
  u32x4 graw[4];
#pragma unroll
  for (int i = 0; i < 4; ++i) graw[i] = *(const u32x4*)(Z + (size_t)(tok0 + wid * 16 + (lane >> 4) + 4 * i) * NIN + ZC_RG + h * 128 + (lane & 15) * 8);
#pragma unroll
  for (int nt = 0; nt < 8; ++nt) { const f32x4 rg = *(const f32x4*)(p.rg + h * 128 + nt * 16 + fq * 4);
    *(LAS u32x2*)(wb + fr * LDR + (nt * 16 + fq * 4) * 2) = (u32x2){cvt_pk_bf16(O[nt][0] * r * rg[0], O[nt][1] * r * rg[1]), cvt_pk_bf16(O[nt][2] * r * rg[2], O[nt][3] * r * rg[3])}; }
#pragma unroll
  for (int i = 0; i < 4; ++i) { const int row = (lane >> 4) + 4 * i, ch = lane & 15;
    float y[8], g[8]; unpack8(*(const LAS u32x4*)(wb + row * LDR + ch * 16), y); unpack8(graw[i], g);
#pragma unroll
    for (int e2 = 0; e2 < 8; ++e2) y[e2] *= silu_f(g[e2]);
    *(u32x4*)(MIX + (size_t)(tok0 + wid * 16 + row) * DM + 1024 + h * 128 + ch * 8) = pack8(y); }
  __syncthreads();
}
__device__ __forceinline__ void sample_item(const Params& p, LAS unsigned char* lds, int item) {
  const int tid = opaque_tid(), wid = __builtin_amdgcn_readfirstlane(tid >> 6), lane = tid & 63;
  int b, h;
  if (gridDim.x == 256) { const int x = item & 7, y = item >> 3, g = x * 8 + (y >> 2); b = g >> 1; h = (g & 1) * 4 + (y & 3); }
  else { b = item >> 3; h = item & 7; }
  const int kvh = h >> 2, R = NTOK_P + b;
  const bf16_t* zr = (const bf16_t*)(p.ws + BUF_Z) + (size_t)R * NIN;
  bf16_t* mixr = (bf16_t*)(p.ws + BUF_MIX) + (size_t)R * DM;
  LAS float* qs = (LAS float*)lds; LAS float* ks = qs + 128; LAS float* vs = qs + 256; LAS float* sc = qs + 384; LAS float* pr = qs + 528; LAS float* part = qs + 672;
  LAS float* qr = qs + 2720; LAS float* kr = qr + 128; LAS float* vv = qr + 256; LAS float* gg = qr + 384;
  const float* rc = (const float*)(p.ws + BUF_ROPE) + 4096 * 64; const float* rsn = rc + 4097 * 64;
  if (wid == 0) { const float a0 = bf2f(zr[ZC_AQ + h * 128 + lane]), a1 = bf2f(zr[ZC_AQ + h * 128 + lane + 64]); const float r = rsqrtf(wave_sum(a0 * a0 + a1 * a1) * (1.0f / 128.0f) + EPS);
    qs[lane] = a0 * r * p.qn[lane]; qs[lane + 64] = a1 * r * p.qn[lane + 64]; }
  else if (wid == 1) { const float a0 = bf2f(zr[ZC_AK + kvh * 128 + lane]), a1 = bf2f(zr[ZC_AK + kvh * 128 + lane + 64]); const float r = rsqrtf(wave_sum(a0 * a0 + a1 * a1) * (1.0f / 128.0f) + EPS);
    ks[lane] = a0 * r * p.kn[lane]; ks[lane + 64] = a1 * r * p.kn[lane + 64]; }
  else if (wid == 2) { vs[lane] = bf2f(zr[ZC_AV + kvh * 128 + lane]); vs[lane + 64] = bf2f(zr[ZC_AV + kvh * 128 + lane + 64]); }
  else if (wid == 3) { const float x1 = bf2f(zr[ZC_RQ + h * 128 + lane]), x2 = bf2f(zr[ZC_RQ + h * 128 + lane + 64]); const float cs = rc[lane], sn = rsn[lane];
    qr[lane] = x1 * cs - x2 * sn; qr[lane + 64] = x1 * sn + x2 * cs; }
  else if (wid == 4) { const float x1 = bf2f(zr[ZC_RK + h * 128 + lane]), x2 = bf2f(zr[ZC_RK + h * 128 + lane + 64]); const float cs = rc[lane], sn = rsn[lane];
    kr[lane] = (x1 * cs - x2 * sn) * RET_K_SCALE; kr[lane + 64] = (x1 * sn + x2 * cs) * RET_K_SCALE; }
  else if (wid == 5) { vv[lane] = bf2f(zr[ZC_RV + h * 128 + lane]); vv[lane + 64] = bf2f(zr[ZC_RV + h * 128 + lane + 64]); }
  else if (wid == 6) { gg[lane] = bf2f(zr[ZC_RG + h * 128 + lane]); gg[lane + 64] = bf2f(zr[ZC_RG + h * 128 + lane + 64]); }
  __syncthreads();
  {
    const int ch = lane & 31, hf = lane >> 5;
    const f32x4 qv = (f32x4){qs[ch * 4], qs[ch * 4 + 1], qs[ch * 4 + 2], qs[ch * 4 + 3]};
    f32x4 kvv[8];
#pragma unroll
    for (int i = 0; i < 8; ++i) kvv[i] = *(const f32x4*)(p.ck + ((size_t)(b * 128 + wid * 16 + i * 2 + hf) * 2 + kvh) * 128 + ch * 4);
#pragma unroll
    for (int i = 0; i < 8; ++i) { float dd = kvv[i][0] * qv[0] + kvv[i][1] * qv[1] + kvv[i][2] * qv[2] + kvv[i][3] * qv[3];
      dd += __shfl_xor(dd, 1); dd += __shfl_xor(dd, 2); dd += __shfl_xor(dd, 4); dd += __shfl_xor(dd, 8); dd += __shfl_xor(dd, 16);
      if (ch == 0) sc[wid * 16 + i * 2 + hf] = dd * ATTN_SCALE; }
    if (wid == 0) { const float dn = wave_sum(qs[lane] * ks[lane] + qs[lane + 64] * ks[lane + 64]); if (lane == 0) sc[128] = dn * ATTN_SCALE; }
  }
  __syncthreads();
  if (wid == 0) { const float sink = p.sinks[h]; const float s0 = sc[lane], s1 = sc[lane + 64], s2 = lane == 0 ? sc[128] : -INFINITY;
    const float mx = fmaxf(wave_max(fmaxf(fmaxf(s0, s1), s2)), sink);
    const float e0 = __expf(s0 - mx), e1 = __expf(s1 - mx), e2 = __expf(s2 - mx);
    const float inv = 1.0f / (wave_sum(e0 + e1 + e2) + __expf(sink - mx));
    pr[lane] = e0 * inv; pr[lane + 64] = e1 * inv; if (lane == 0) pr[128] = e2 * inv; }
  __syncthreads();
  {
    const int ch = lane & 31, hf = lane >> 5;
    f32x4 vvv[8];
#pragma unroll
    for (int i = 0; i < 8; ++i) vvv[i] = *(const f32x4*)(p.cv + ((size_t)(b * 128 + wid * 16 + i * 2 + hf) * 2 + kvh) * 128 + ch * 4);
    f32x4 a4 = (f32x4){0.f, 0.f, 0.f, 0.f};
#pragma unroll
    for (int i = 0; i < 8; ++i) a4 += vvv[i] * pr[wid * 16 + i * 2 + hf];
#pragma unroll
    for (int j = 0; j < 4; ++j) a4[j] += __shfl_xor(a4[j], 32);
    if (hf == 0) { part[wid * 128 + ch * 4] = a4[0]; part[wid * 128 + ch * 4 + 1] = a4[1]; part[wid * 128 + ch * 4 + 2] = a4[2]; part[wid * 128 + ch * 4 + 3] = a4[3]; }
  }
  __syncthreads();
  if (tid < 128) { float o = pr[128] * vs[tid];
#pragma unroll
    for (int w = 0; w < 8; ++w) o += part[w * 128 + tid];
    mixr[h * 128 + tid] = (bf16_t)(cvt_pk_bf16(o, 0.f) & 0xffffu); }
  if ((h & 3) == 0) {
    for (int idx = tid; idx < 128 * 32; idx += 512) { const int w = idx >> 5, d4 = (idx & 31) * 4;
      const size_t src = ((size_t)(b * 128 + w + 1) * 2 + kvh) * 128 + d4, dst = ((size_t)(b * 128 + w) * 2 + kvh) * 128 + d4;
      f32x4 kx, vx;
      if (w < 127) { kx = *(const f32x4*)(p.ck + src); vx = *(const f32x4*)(p.cv + src); }
      else { kx = (f32x4){ks[d4], ks[d4 + 1], ks[d4 + 2], ks[d4 + 3]}; vx = (f32x4){vs[d4], vs[d4 + 1], vs[d4 + 2], vs[d4 + 3]}; }
      __builtin_nontemporal_store(kx, (f32x4*)(p.out + O_KWS + dst)); __builtin_nontemporal_store(vx, (f32x4*)(p.out + O_VWS + dst)); }
  }
  __syncthreads();
  {
    const float gamma = 1.0f - exp2f(-5.0f - (float)h);
    const int dv4 = (tid & 31) * 4, dkg = tid >> 5;
    const f32x4 v4 = (f32x4){vv[dv4], vv[dv4 + 1], vv[dv4 + 2], vv[dv4 + 3]};
    f32x4 o4 = (f32x4){0.f, 0.f, 0.f, 0.f};
#pragma unroll
    for (int i = 0; i < 8; ++i) { const int dk = dkg + 16 * i; const size_t off = ((size_t)(b * 8 + h) * 128 + dk) * 128 + dv4;
      const f32x4 sn = __builtin_nontemporal_load((const f32x4*)(p.st + off)) * gamma + v4 * kr[dk];
      __builtin_nontemporal_store(sn, (f32x4*)(p.out + O_RSS + off)); o4 += sn * qr[dk]; }
    part[dkg * 128 + dv4] = o4[0]; part[dkg * 128 + dv4 + 1] = o4[1]; part[dkg * 128 + dv4 + 2] = o4[2]; part[dkg * 128 + dv4 + 3] = o4[3];
  }
  __syncthreads();
  if (wid == 0) { float o0 = 0.f, o1 = 0.f;
#pragma unroll
    for (int g = 0; g < 16; ++g) { o0 += part[g * 128 + lane]; o1 += part[g * 128 + lane + 64]; }
    const float r = rsqrtf(wave_sum(o0 * o0 + o1 * o1) * (1.0f / 128.0f) + EPS);
    const float y0 = o0 * r * p.rg[h * 128 + lane] * silu_f(gg[lane]), y1 = o1 * r * p.rg[h * 128 + lane + 64] * silu_f(gg[lane + 64]);
    mixr[1024 + h * 128 + lane] = (bf16_t)(cvt_pk_bf16(y0, 0.f) & 0xffffu); mixr[1024 + h * 128 + lane + 64] = (bf16_t)(cvt_pk_bf16(y1, 0.f) & 0xffffu); }
  __syncthreads();
}


template <int NB, int U>
__device__ __forceinline__ void skinny_mma(const bf16_t* A, const bf16_t* B0, const bf16_t* B1, int K, LAS float* red, float (&out)[NB]) {
  const int tid = opaque_tid(), wid = __builtin_amdgcn_readfirstlane(tid >> 6), lane = tid & 63, fr = lane & 15, fq = lane >> 4;
  const int kw = K >> 3, nks = kw >> 5;
  f32x4 acc[NB][2];
#pragma unroll
  for (int nb = 0; nb < NB; ++nb) { acc[nb][0] = (f32x4){0.f, 0.f, 0.f, 0.f}; acc[nb][1] = (f32x4){0.f, 0.f, 0.f, 0.f}; }
  const size_t off = (size_t)fr * K + wid * kw + fq * 8;
  const bf16_t* a0p = A + off; const bf16_t* a1p = a0p + (size_t)16 * K; const bf16_t* b0p = B0 + off; const bf16_t* b1p = B1 + off;
  for (int ks0 = 0; ks0 < nks; ks0 += U) {
    bf16x8 a0[U], a1[U], b0[U], b1[U];
#pragma unroll
    for (int u = 0; u < U; ++u) { a0[u] = *(const bf16x8*)(a0p + (ks0 + u) * 32); a1[u] = *(const bf16x8*)(a1p + (ks0 + u) * 32); b0[u] = *(const bf16x8*)(b0p + (ks0 + u) * 32);
      if (NB == 2) b1[u] = *(const bf16x8*)(b1p + (ks0 + u) * 32); else b1[u] = b0[u]; }
#pragma unroll
    for (int u = 0; u < U; ++u) { acc[0][0] = MFMA16(b0[u], a0[u], acc[0][0]); acc[0][1] = MFMA16(b0[u], a1[u], acc[0][1]);
      if (NB == 2) { acc[NB - 1][0] = MFMA16(b1[u], a0[u], acc[NB - 1][0]); acc[NB - 1][1] = MFMA16(b1[u], a1[u], acc[NB - 1][1]); } }
  }
#pragma unroll
  for (int nb = 0; nb < NB; ++nb)
#pragma unroll
    for (int hf = 0; hf < 2; ++hf) *(LAS f32x4*)(red + ((nb * 8 + wid) * 32 + hf * 16 + fr) * 16 + fq * 4) = acc[nb][hf];
  __syncthreads();
  const int row = tid >> 4, col = tid & 15;
#pragma unroll
  for (int nb = 0; nb < NB; ++nb) { float s = 0.f;
#pragma unroll
    for (int w = 0; w < 8; ++w) s += red[((nb * 8 + w) * 32 + row) * 16 + col];
    out[nb] = s; }
  __syncthreads();
}
#define SKINNY_LOOP(ntasks, nwg) const int _r = (nwg) % G, _nb = _r ? G - _r : G; const int _me = G - 1 - bid; if (_me < _nb) for (int task = _me; task < (ntasks); task += _nb)

__device__ __forceinline__ void skinny_p1(const Params& p, LAS unsigned char* lds, int G, int bid) {
  unsigned char* ws = p.ws; const int tid = opaque_tid(), row = tid >> 4, col = tid & 15;
  SKINNY_LOOP(NIN / 16, (NTOK_P / 256) * (NIN / 256)) { const int c0 = task * 16; float v[1];
    skinny_mma<1, 8>((const bf16_t*)(ws + BUF_A) + (size_t)NTOK_P * DM, (const bf16_t*)(ws + W_IN) + (size_t)c0 * DM, nullptr, DM, (LAS float*)lds, v);
    ((bf16_t*)(ws + BUF_Z))[(size_t)(NTOK_P + row) * NIN + c0 + col] = (bf16_t)(cvt_pk_bf16(v[0], 0.f) & 0xffffu); }
}
__device__ __forceinline__ void skinny_p3(const Params& p, LAS unsigned char* lds, int G, int bid) {
  unsigned char* ws = p.ws; const int tid = opaque_tid(), row = tid >> 4, col = tid & 15; float* rs1 = (float*)(ws + BUF_RS);
  SKINNY_LOOP(DM / 16, (NTOK_P / 256) * (DM / 256)) { const int c = task * 16 + col; float v[1];
    skinny_mma<1, 8>((const bf16_t*)(ws + BUF_MIX) + (size_t)NTOK_P * DM, (const bf16_t*)(ws + W_OUT) + (size_t)(task * 16) * DM, nullptr, DM, (LAS float*)lds, v);
    const float hn = p.x_s[(size_t)row * DM + c] + v[0];
    ((bf16_t*)(ws + BUF_B))[(size_t)(NTOK_P + row) * DM + c] = (bf16_t)(cvt_pk_bf16(hn * p.fn[c], 0.f) & 0xffffu);
    float ss = hn * hn; ss += __shfl_xor(ss, 1); ss += __shfl_xor(ss, 2); ss += __shfl_xor(ss, 4); ss += __shfl_xor(ss, 8);
    if (col == 0) atomicAdd(rs1 + NTOK_P + row, ss); }
}
__device__ __forceinline__ void skinny_p5(const Params& p, LAS unsigned char* lds, int G, int bid) {
  unsigned char* ws = p.ws; const int tid = opaque_tid(), row = tid >> 4, col = tid & 15; float* rs2 = (float*)(ws + BUF_RS) + M_PAD;
  SKINNY_LOOP(DM / 16, (NTOK_P / 256) * (DM / 256)) { const int c = task * 16 + col; float v[1];
    skinny_mma<1, 11>((const bf16_t*)(ws + BUF_Z) + (size_t)NTOK_P * DFF, (const bf16_t*)(ws + W_DOWN) + (size_t)(task * 16) * DFF, nullptr, DFF, (LAS float*)lds, v);
    const float hn = bf2f(((const bf16_t*)(ws + BUF_B))[(size_t)(NTOK_P + row) * DM + c]) / p.fn[c] + v[0];
    ((bf16_t*)(ws + BUF_A))[(size_t)(NTOK_P + row) * DM + c] = (bf16_t)(cvt_pk_bf16(hn * p.pn[c], 0.f) & 0xffffu);
    float ss = hn * hn; ss += __shfl_xor(ss, 1); ss += __shfl_xor(ss, 2); ss += __shfl_xor(ss, 4); ss += __shfl_xor(ss, 8);
    if (col == 0) atomicAdd(rs2 + NTOK_P + row, ss); }
}
__device__ __forceinline__ void skinny_p4(const Params& p, LAS unsigned char* lds, int G, int bid) {
  unsigned char* ws = p.ws; const int tid = opaque_tid(), row = tid >> 4, col = tid & 15; const float* rs1 = (const float*)(ws + BUF_RS);
  SKINNY_LOOP(DFF / 16, (NTOK_P / 256) * (2 * DFF / 256)) { const int c0 = task * 16, gr = (c0 >> 7) * 256 + (c0 & 127); float v[2];
    skinny_mma<2, 8>((const bf16_t*)(ws + BUF_B) + (size_t)NTOK_P * DM, (const bf16_t*)(ws + W_GU) + (size_t)gr * DM, (const bf16_t*)(ws + W_GU) + (size_t)(gr + 128) * DM, DM, (LAS float*)lds, v);
    const float r = rsqrtf(rs1[NTOK_P + row] * (1.0f / DM) + EPS);
    ((bf16_t*)(ws + BUF_Z))[(size_t)(NTOK_P + row) * DFF + c0 + col] = (bf16_t)(cvt_pk_bf16(silu_f(v[0] * r) * (v[1] * r), 0.f) & 0xffffu); }
}
__device__ __forceinline__ void skinny_p6(const Params& p, LAS unsigned char* lds, int G, int bid) {
  unsigned char* ws = p.ws; const int tid = opaque_tid(), row = tid >> 4, col = tid & 15; const float* rs2 = (const float*)(ws + BUF_RS) + M_PAD;
  SKINNY_LOOP(DM / 16, (NTOK_P / 256) * (DM / 256)) { const int c0 = task * 16; float v[1], t[1];
    skinny_mma<1, 8>((const bf16_t*)(ws + BUF_A) + (size_t)NTOK_P * DM, (const bf16_t*)(ws + W_PG) + (size_t)c0 * DM, nullptr, DM, (LAS float*)lds, v);
    skinny_mma<1, 1>((const bf16_t*)(ws + BUF_P) + (size_t)NTOK_P * PLE, (const bf16_t*)(ws + W_PLE) + (size_t)c0 * PLE, nullptr, PLE, (LAS float*)lds, t);
    const float r = rsqrtf(rs2[NTOK_P + row] * (1.0f / DM) + EPS);
    const int c = c0 + col; const float h2 = bf2f(((const bf16_t*)(ws + BUF_A))[(size_t)(NTOK_P + row) * DM + c]) / p.pn[c];
    p.out[O_YS + (size_t)row * DM + c] = h2 + t[0] * sigmoid_f(v[0] * r); }
}

__device__ __forceinline__ void tail_wout(const Params& p, LAS unsigned char* lds, int G, int bid) {
  const int r = ((NTOK_P / 256) * (NIN / 256)) % G, nb = r ? G - r : G, me = G - 1 - bid;
  if (me < nb) transpose_jobs<1>(p, lds, me, nb);
}
__device__ __forceinline__ void tail_wdown(const Params& p, LAS unsigned char* lds, int G, int bid) {
  const int r = ((NTOK_P / 256) * (2 * DFF / 256)) % G, nb = r ? G - r : G, me = G - 1 - bid;
  if (me < nb) transpose_jobs<2>(p, lds, me, nb);
}

__global__ void __launch_bounds__(512, 2) hybrid_fwd(Params p) {
  extern __shared__ __attribute__((aligned(16))) unsigned char shm[];
  cg::grid_group grid = cg::this_grid();
  LAS unsigned char* lds = (LAS unsigned char*)shm;
  unsigned char* ws = p.ws;
  const int G = (int)gridDim.x, bid = (int)blockIdx.x;
  bf16_t* bufA = (bf16_t*)(ws + BUF_A); bf16_t* bufB = (bf16_t*)(ws + BUF_B); bf16_t* bufZ = (bf16_t*)(ws + BUF_Z);
  float* rs1 = (float*)(ws + BUF_RS); float* rs2 = rs1 + M_PAD;
  volatile LAS unsigned* st = (volatile LAS unsigned*)(lds + LDS_PHASE_BYTES);
  if (threadIdx.x == 0) { st[0] = 0u; st[1] = 0u; }
  __syncthreads();
  const XcdBarrier xb = xcd_barrier_post((unsigned*)(ws + BUF_BAR), st);

  phase_prep(p, lds);
  if (p.never) grid.sync();
  xcd_barrier(xb);
  { Gemm g{bufA, (const bf16_t*)(ws + W_IN), NTOK_P, NIN, DM}; StaticOrder S; S.init(NTOK_P, NIN, G, bid); EpiZ E{bufZ, NIN};
    gemm_phase<EpiZ, StaticOrder, false>(lds, g, S, E, nullptr); }
  skinny_p1(p, lds, G, bid);
  tail_wout(p, lds, G, bid);
  xcd_barrier(xb);
  for (int it = bid; it < 1280; it += G) { if (it < 512) attn_item(p, lds, it); else if (it < 1024) retkv_item(p, lds, it - 512); else sample_item(p, lds, it - 1024); }
  xcd_barrier(xb);
  phase_scan(p);
  xcd_barrier(xb);
  for (int it = bid; it < 512; it += G) retout_item(p, lds, it);
  xcd_barrier(xb);
  { Gemm g{(const bf16_t*)(ws + BUF_MIX), (const bf16_t*)(ws + W_OUT), NTOK_P, DM, DM}; StaticOrder S; S.init(NTOK_P, DM, G, bid); EpiRes3 E{bufA, (const float*)(ws + BUF_XS), p.an, bufB, p.fn, rs1};
    gemm_phase<EpiRes3, StaticOrder, false>(lds, g, S, E, nullptr); }
  skinny_p3(p, lds, G, bid);
  xcd_barrier(xb);
  { Gemm g{bufB, (const bf16_t*)(ws + W_GU), NTOK_P, 2 * DFF, DM}; StaticOrder S; S.init(NTOK_P, 2 * DFF, G, bid); EpiAct E{bufZ, rs1};
    gemm_phase<EpiAct, StaticOrder, false>(lds, g, S, E, nullptr); }
  skinny_p4(p, lds, G, bid);
  tail_wdown(p, lds, G, bid);
  xcd_barrier(xb);
  { Gemm g{bufZ, (const bf16_t*)(ws + W_DOWN), NTOK_P, DM, DFF}; StaticOrder S; S.init(NTOK_P, DM, G, bid); EpiRes5 E{bufB, p.fn, bufA, p.pn, rs2};
    gemm_phase<EpiRes5, StaticOrder, false>(lds, g, S, E, nullptr); }
  { Gemm g{(const bf16_t*)(ws + BUF_P), (const bf16_t*)(ws + W_PLE), NTOK_P, DM, PLE}; StaticOrder S; S.init(NTOK_P, DM, G, bid); EpiZ E{bufB, DM};
    gemm_phase<EpiZ, StaticOrder, false>(lds, g, S, E, nullptr); }
  skinny_p5(p, lds, G, bid);
  xcd_barrier(xb);
  { Gemm g{bufA, (const bf16_t*)(ws + W_PG), NTOK_P, DM, DM}; StaticOrder S; S.init(NTOK_P, DM, G, bid); EpiPle E{p.out, bufA, p.pn, bufB, rs2};
    gemm_phase<EpiPle, StaticOrder, false>(lds, g, S, E, nullptr); }
  skinny_p6(p, lds, G, bid);
}

extern "C" void kernel_launch(void* const* d_in, const int* in_sizes, int n_in, void* d_out, int out_size, void* d_ws, size_t ws_size, hipStream_t stream) {
  static int grid_blocks = 0;
  if (!grid_blocks) {
    int dev = 0, cus = 0, per_cu = 0;
    (void)hipGetDevice(&dev);
    (void)hipDeviceGetAttribute(&cus, hipDeviceAttributeMultiprocessorCount, dev);
    (void)hipFuncSetAttribute((const void*)hybrid_fwd, hipFuncAttributeMaxDynamicSharedMemorySize, LDS_BYTES);
    (void)hipOccupancyMaxActiveBlocksPerMultiprocessor(&per_cu, hybrid_fwd, 512, (size_t)LDS_BYTES);
    if (per_cu < 1) per_cu = 1;
    grid_blocks = cus * per_cu;
    if (ws_size < WS_END) fprintf(stderr, "workspace too small: %zu < %zu\n", ws_size, (size_t)WS_END);
  }
  Params p{};
  p.x_p = (const float*)d_in[0]; p.x_s = (const float*)d_in[1]; p.ck = (const float*)d_in[2]; p.cv = (const float*)d_in[3]; p.st = (const float*)d_in[4];
  p.p_p = (const float*)d_in[5]; p.p_s = (const float*)d_in[6]; p.an = (const float*)d_in[7]; p.w_in = (const float*)d_in[8]; p.qn = (const float*)d_in[9];
  p.kn = (const float*)d_in[10]; p.sinks = (const float*)d_in[11]; p.rg = (const float*)d_in[12]; p.w_out = (const float*)d_in[13]; p.fn = (const float*)d_in[14];
  p.w_gate = (const float*)d_in[15]; p.w_up = (const float*)d_in[16]; p.w_down = (const float*)d_in[17]; p.pn = (const float*)d_in[18]; p.w_ple = (const float*)d_in[19];
  p.w_pg = (const float*)d_in[20]; p.out = (float*)d_out; p.ws = (unsigned char*)d_ws;
  (void)hipMemsetAsync((unsigned char*)d_ws + BUF_BAR, 0, (size_t)XCD_BAR_WORDS * 4, stream);
  void* args[] = {&p};
  hipError_t e = hipLaunchCooperativeKernel((const void*)hybrid_fwd, dim3(grid_blocks), dim3(512), args, (size_t)LDS_BYTES, stream);
  if (e != hipSuccess) fprintf(stderr, "cooperative launch failed: %s (grid %d)\n", hipGetErrorString(e), grid_blocks);
}
```
